# Optimizing an MI355X kernel written in HIP

```python
import math
import jax, jax.numpy as jnp
from jax import lax
import numpy as np

D_MODEL = 1024
BATCH = 16
SEQ = 2048
DEPTH = 2

D_MIX = D_MODEL
D_A = D_MIX // 2
D_B = D_MIX - D_A
G_A = 8
DG_A = D_A // G_A
H_B = 8
DH_B = D_B // H_B
CHUNK = 128
Q_BLOCK = 128
PROJ_COLS = 2 * D_A + 3 * D_B
PEER_HEADS = 8
PEER_DK = 128
PEER_HALF = PEER_DK // 2
N_KEYS = 128
N_EXPERTS = N_KEYS * N_KEYS
PEER_TOPK = 16
PEER_TOK_BLOCK = 128
EPS = 1e-6

kernel_name = "hybrid_gmlp_stickbreak_peer_adaln"


def rms_norm(x, g):
    xf = x.astype(jnp.float32)
    y = xf * lax.rsqrt(jnp.mean(xf * xf, axis=-1, keepdims=True) + EPS)
    return (y * g.astype(jnp.float32)).astype(x.dtype)


def group_rms_norm(x, g, n_groups):
    shp = x.shape
    xg = x.reshape(shp[:-1] + (n_groups, shp[-1] // n_groups))
    xf = xg.astype(jnp.float32)
    y = xf * lax.rsqrt(jnp.mean(xf * xf, axis=-1, keepdims=True) + EPS)
    y = y.reshape(shp) * g.astype(jnp.float32)
    return y.astype(x.dtype)


def chunked_gmlp(u, v, w_s, b_s):
    B, T, _ = v.shape
    nc = T // CHUNK
    vg = v.reshape(B, nc, CHUNK, G_A, DG_A).astype(jnp.float32)
    mu = jnp.mean(vg, axis=-1, keepdims=True)
    var = jnp.mean(jnp.square(vg - mu), axis=-1, keepdims=True)
    vn = ((vg - mu) * lax.rsqrt(var + EPS)).astype(v.dtype)
    w_causal = jnp.tril(w_s)
    s = jnp.einsum("gts,bnsgd->bntgd", w_causal, vn)
    s = s + jnp.transpose(b_s)[None, None, :, :, None]
    return u * s.reshape(B, T, D_A)


def stick_breaking_attention(q, k, v):
    B, H, T, d = q.shape
    scale = 1.0 / math.sqrt(d)
    outs = []
    for i in range(T // Q_BLOCK):
        t0 = i * Q_BLOCK
        kend = t0 + Q_BLOCK
        qb = q[:, :, t0:kend]
        kb = k[:, :, :kend]
        vb = v[:, :, :kend]
        z = jnp.einsum("bhtd,bhsd->bhts", qb, kb).astype(jnp.float32) * scale
        t_idx = t0 + jnp.arange(Q_BLOCK)[:, None]
        s_idx = jnp.arange(kend)[None, :]
        mask = s_idx < t_idx
        log1m = jnp.where(mask, jax.nn.log_sigmoid(-z), 0.0)
        tail = lax.cumsum(log1m, axis=3, reverse=True) - log1m
        a = jnp.where(mask, jnp.exp(jax.nn.log_sigmoid(z) + tail), 0.0)
        outs.append(jnp.einsum("bhts,bhsd->bhtd", a.astype(v.dtype), vb))
    return jnp.concatenate(outs, axis=2)


def peer_layer(h, w_q, k1, k2, u_tab, v_tab):
    B, T, D = h.shape
    q = jnp.einsum("btd,dk->btk", h, w_q).reshape(B, T, PEER_HEADS, PEER_DK)
    q1, q2 = q[..., :PEER_HALF], q[..., PEER_HALF:]
    s1 = jnp.einsum("bthd,nd->bthn", q1, k1)
    s2 = jnp.einsum("bthd,nd->bthn", q2, k2)
    v1, i1 = lax.top_k(s1, PEER_TOPK)
    v2, i2 = lax.top_k(s2, PEER_TOPK)
    cand = (v1[..., :, None] + v2[..., None, :]).reshape(B, T, PEER_HEADS, PEER_TOPK * PEER_TOPK)
    cidx = (i1[..., :, None] * N_KEYS + i2[..., None, :]).reshape(B, T, PEER_HEADS, PEER_TOPK * PEER_TOPK)
    sc, pos = lax.top_k(cand, PEER_TOPK)
    eidx = jnp.take_along_axis(cidx, pos, axis=-1)
    g = jax.nn.softmax(sc.astype(jnp.float32), axis=-1).astype(h.dtype)
    n_blk = (B * T) // PEER_TOK_BLOCK
    HK = PEER_HEADS * PEER_TOPK
    h_blk = h.reshape(n_blk, PEER_TOK_BLOCK, D)
    idx_blk = eidx.reshape(n_blk, PEER_TOK_BLOCK, HK)
    g_blk = g.reshape(n_blk, PEER_TOK_BLOCK, HK)

    def eval_block(args):
        hb, ib, gb = args
        ue = jnp.take(u_tab, ib, axis=0)
        act = jax.nn.gelu(jnp.einsum("tkd,td->tk", ue, hb))
        ve = jnp.take(v_tab, ib, axis=0)
        return jnp.einsum("tk,tkd->td", gb * act, ve)

    y = lax.map(eval_block, (h_blk, idx_blk, g_blk))
    return y.reshape(B, T, D)


def setup_inputs(seed: int = 0) -> dict:
    key = jax.random.key(seed)
    ks = jax.random.split(key, 20)
    f = jnp.float32
    L = DEPTH
    x = jax.random.normal(ks[0], (BATCH, SEQ, D_MODEL), f)
    c = jax.random.normal(ks[1], (BATCH, D_MODEL), f)
    ada_w = jax.random.normal(ks[2], (L, D_MODEL, 6 * D_MODEL), f) * (0.5 * D_MODEL ** -0.5)
    ada_b = jax.random.normal(ks[3], (L, 6 * D_MODEL), f) * 0.02
    norm1_g = 1.0 + 0.02 * jax.random.normal(ks[4], (L, D_MODEL), f)
    norm2_g = 1.0 + 0.02 * jax.random.normal(ks[5], (L, D_MODEL), f)
    w_in = jax.random.normal(ks[6], (L, D_MODEL, PROJ_COLS), f) * D_MODEL ** -0.5
    sgu_w = jax.random.normal(ks[7], (L, G_A, CHUNK, CHUNK), f) * CHUNK ** -0.5
    sgu_b = 1.0 + 0.02 * jax.random.normal(ks[8], (L, G_A, CHUNK), f)
    out_norm_a = 1.0 + 0.02 * jax.random.normal(ks[9], (L, D_A), f)
    out_norm_b = 1.0 + 0.02 * jax.random.normal(ks[10], (L, D_B), f)
    w_out = jax.random.normal(ks[11], (L, D_MIX, D_MODEL), f) * D_MIX ** -0.5
    peer_wq = jax.random.normal(ks[12], (L, D_MODEL, PEER_HEADS * PEER_DK), f) * D_MODEL ** -0.5
    peer_k1 = jax.random.normal(ks[13], (L, N_KEYS, PEER_HALF), f) * PEER_HALF ** -0.5
    peer_k2 = jax.random.normal(ks[14], (L, N_KEYS, PEER_HALF), f) * PEER_HALF ** -0.5
    peer_u = jax.random.normal(ks[15], (L, N_EXPERTS, D_MODEL), f) * D_MODEL ** -0.5
    peer_v = jax.random.normal(ks[16], (L, N_EXPERTS, D_MODEL), f) * PEER_HEADS ** -0.5
    final_g = 1.0 + 0.02 * jax.random.normal(ks[17], (D_MODEL,), f)
    return {"x": x, "c": c, "ada_w": ada_w, "ada_b": ada_b, "norm1_g": norm1_g,
            "norm2_g": norm2_g, "w_in": w_in, "sgu_w": sgu_w, "sgu_b": sgu_b,
            "out_norm_a": out_norm_a, "out_norm_b": out_norm_b, "w_out": w_out,
            "peer_wq": peer_wq, "peer_k1": peer_k1, "peer_k2": peer_k2,
            "peer_u": peer_u, "peer_v": peer_v, "final_g": final_g}


def reference(x, c, ada_w, ada_b, norm1_g, norm2_g, w_in, sgu_w, sgu_b,
              out_norm_a, out_norm_b, w_out, peer_wq, peer_k1, peer_k2,
              peer_u, peer_v, final_g):
    B, T, D = x.shape
    c_act = jax.nn.silu(c)
    for l in range(DEPTH):
        mod = jnp.einsum("bd,de->be", c_act, ada_w[l]) + ada_b[l]
        sh1, sc1, gt1, sh2, sc2, gt2 = [m[:, None, :] for m in jnp.split(mod, 6, axis=-1)]

        h = rms_norm(x, norm1_g[l]) * (1.0 + sc1) + sh1
        proj = jnp.einsum("btd,dc->btc", h, w_in[l])
        u_a = jax.nn.gelu(proj[..., :D_A])
        v_a = jax.nn.gelu(proj[..., D_A:2 * D_A])
        q_b = proj[..., 2 * D_A:2 * D_A + D_B]
        k_b = proj[..., 2 * D_A + D_B:2 * D_A + 2 * D_B]
        v_b = proj[..., 2 * D_A + 2 * D_B:]
        y_a = chunked_gmlp(u_a, v_a, sgu_w[l], sgu_b[l])
        to_heads = lambda z: z.reshape(B, T, H_B, DH_B).transpose(0, 2, 1, 3)
        y_b = stick_breaking_attention(to_heads(q_b), to_heads(k_b), to_heads(v_b))
        y_b = y_b.transpose(0, 2, 1, 3).reshape(B, T, D_B)
        y_mix = jnp.concatenate([group_rms_norm(y_a, out_norm_a[l], G_A),
                                 group_rms_norm(y_b, out_norm_b[l], H_B)], axis=-1)
        x = x + gt1 * jnp.einsum("btc,cd->btd", y_mix, w_out[l])

        h2 = rms_norm(x, norm2_g[l]) * (1.0 + sc2) + sh2
        x = x + gt2 * peer_layer(h2, peer_wq[l], peer_k1[l], peer_k2[l], peer_u[l], peer_v[l])
    return rms_norm(x, final_g)
```

```cpp
#include <hip/hip_runtime.h>
#include <cstdio>
#include <cstdint>
namespace pg8 {
#define PG8_LAS __attribute__((address_space(3)))
typedef unsigned short bf16_t;
typedef short bf16x8 __attribute__((ext_vector_type(8)));
typedef float f32x4 __attribute__((ext_vector_type(4)));
typedef unsigned u32x4 __attribute__((ext_vector_type(4)));
constexpr int BM = 256, BK = 64, HALF = 128, HTB = HALF * BK * 2  , STAGE_BYTES = 8 * HTB, NXCD = 8, WGM = 8;

__host__ __device__ __forceinline__ int lds_byte(int r, int c) { const int st = (r >> 4) * 2 + (c >> 5), rr = r & 15, cc = c & 31, ob = rr * 64 + cc * 2; return st * 1024 + (ob ^ (((ob >> 9) & 1) << 5)); }
__host__ __device__ __forceinline__ void stage_rc(int b, int& R, int& C) { const int st = b / 1024, sb = b % 1024, swz = sb ^ (((sb >> 9) & 1) << 5); R = (st >> 1) * 16 + swz / 64; C = (st & 1) * 32 + (swz % 64) / 2; }
__host__ __device__ __forceinline__ int perm32(int rho) { const int n = rho >> 4, i = rho & 15; return 8 * (i >> 2) + 4 * n + (i & 3); }

struct Unit { int pm, pn; };
struct Gemm { const bf16_t* A; const bf16_t* Bt; int M, N, K; };

struct StaticOrder {
    int nM, nN, nwg, G, c;
    __host__ __device__ void init(int M, int N, int G_, int c_) { nM = M / BM; nN = N / BM; nwg = nM * nN; G = G_; c = c_; }
    __host__ __device__ bool next(int i, Unit& u) const {
        const long L = (long)i * G + c; if (L >= nwg) return false;
        int wgid = (int)L; { const int q = nwg / NXCD, r = nwg % NXCD, xcd = wgid % NXCD, off = wgid / NXCD; wgid = (xcd < r ? xcd * (q + 1) : r * (q + 1) + (xcd - r) * q) + off; }
        const int nig = WGM * nN, gid = wgid / nig, fm = gid * WGM, gsz = (nM - fm) < WGM ? (nM - fm) : WGM;
        u.pm = fm + ((wgid % nig) % gsz); u.pn = (wgid % nig) / gsz; return true;
    }
    __device__ __forceinline__ void a_ready(const Unit&) const {}
    __device__ __forceinline__ void done(const Unit&) const {}
    __device__ __forceinline__ size_t b_shift(const Unit&) const { return 0; }
};
struct BatchOrder : StaticOrder {
    size_t bs;
    __device__ __forceinline__ size_t b_shift(const Unit& u) const { return (size_t)(u.pm >> 3) * bs; }
};

__device__ __forceinline__ unsigned cvt_pk_bf16(float lo, float hi) { unsigned r; asm volatile("v_cvt_pk_bf16_f32 %0, %1, %2" : "=v"(r) : "v"(lo), "v"(hi)); return r; }
typedef float f32x2 __attribute__((ext_vector_type(2)));
__device__ __forceinline__ f32x2 gelu_pk(f32x2 v) {
    const f32x2 av = __builtin_elementwise_abs(v), d = av * 0.2316418882f + 1.0f;
    f32x2 t; t.x = __builtin_amdgcn_rcpf(d.x); t.y = __builtin_amdgcn_rcpf(d.y);
    f32x2 q = t * 0.5307027145f + (-0.7265760135f); q = q * t + 0.7107068705f; q = q * t + (-0.142248368f); q = q * t + 0.127414796f; q = q * t;
    const f32x2 s = (v * v) * (-0.72134752044f);
    f32x2 e; e.x = __builtin_amdgcn_exp2f(s.x); e.y = __builtin_amdgcn_exp2f(s.y);
    const f32x2 m = v * (q * e), r = v - m;
    f32x2 o; o.x = v.x < 0.f ? m.x : r.x; o.y = v.y < 0.f ? m.y : r.y; return o;
}

template <int ACT  > struct EpiBf16 {
    static constexpr bool PERM = true, AFTER_DRAIN = false; static_assert(ACT == 0 || ACT == 1, "EpiBf16: ACT is 0 (none) or 1 (gelu_pk)");
    bf16_t* O; int ldc; const float* bias; int split_cols; size_t split_stride; float scale0;
    __device__ __forceinline__ void operator()(const f32x4 (&acc)[2][2][4][2], const Unit& u, int wr, int wc, int fr, int fq) const {
        const int row0 = u.pm * BM + wr * 64 + fr; int colt = u.pn * BM; bf16_t* base = O;
        float sc = 1.f; if (split_cols) { const int t = colt / split_cols; base += (size_t)t * split_stride; colt -= t * split_cols; if (t == 0) sc = scale0; }
        const int col0 = colt + wc * 32 + 8 * fq, bcol0 = u.pn * BM + wc * 32 + 8 * fq;
        f32x4 bv[2][2];
#pragma unroll
        for (int bj = 0; bj < 2; ++bj)
#pragma unroll
            for (int n = 0; n < 2; ++n) bv[bj][n] = bias ? *(const f32x4*)(bias + bcol0 + bj * HALF + 4 * n) : (f32x4){0.f, 0.f, 0.f, 0.f};
#pragma unroll
        for (int ai = 0; ai < 2; ++ai)
#pragma unroll
            for (int m = 0; m < 4; ++m) { bf16_t* rowp = base + (size_t)(row0 + ai * HALF + m * 16) * ldc + col0;
#pragma unroll
                for (int bj = 0; bj < 2; ++bj) { f32x4 v0 = acc[ai][bj][m][0] + bv[bj][0], v1 = acc[ai][bj][m][1] + bv[bj][1];
                    if (ACT == 1) { f32x2 a = gelu_pk((f32x2){v0[0], v0[1]}), b = gelu_pk((f32x2){v0[2], v0[3]}), c = gelu_pk((f32x2){v1[0], v1[1]}), d = gelu_pk((f32x2){v1[2], v1[3]});
                        v0 = (f32x4){a.x, a.y, b.x, b.y}; v1 = (f32x4){c.x, c.y, d.x, d.y}; }
                    v0 = v0 * sc; v1 = v1 * sc; u32x4 w; w.x = cvt_pk_bf16(v0[0], v0[1]); w.y = cvt_pk_bf16(v0[2], v0[3]); w.z = cvt_pk_bf16(v1[0], v1[1]); w.w = cvt_pk_bf16(v1[2], v1[3]);
                    *(u32x4*)(rowp + bj * HALF) = w; } }
    }
};

template <class Epi, class Sched, bool ALIGN_EPI = false, bool SP2 = false>
__device__ __forceinline__ void gemm_phase(PG8_LAS unsigned char* lds, const Gemm g, const Sched& S, const Epi& E) {
    int tid_ = threadIdx.x; asm volatile("" : "+v"(tid_));
    const int tid = tid_, wid = __builtin_amdgcn_readfirstlane(tid >> 6), lane = tid & 63, wr = wid >> 2, wc = wid & 3, fr = lane & 15, fq = lane >> 4;
    const int K = g.K, nt = K / BK;
    unsigned voffA[2], voffB[2];
#pragma unroll
    for (int i = 0; i < 2; ++i) { int R, C; stage_rc(tid * 16 + i * 8192, R, C); const int Rb = Epi::PERM ? ((R & ~31) + perm32(R & 31)) : R;
        voffA[i] = (unsigned)(R * K + C) * 2u; voffB[i] = (unsigned)(Rb * K + C) * 2u; }
    const size_t kstep = (size_t)(BK * 2);
    const size_t hstep = (size_t)HALF * K * 2;
    const size_t tstep = 2 * hstep;
    const unsigned ldsw = (unsigned)wid * 1024u;
    const int aoff = lds_byte(wr * 64 + fr, fq * 8), boff = lds_byte(wc * 32 + fr, fq * 8);
#define PG8_SA(b, h) (((b) * 2 + (h)) * HTB)
#define PG8_SB(b, h) ((4 + (b) * 2 + (h)) * HTB)
#define PG8_STAGE(bufoff, gbase, voff) do { _Pragma("unroll") for (int _i = 0; _i < 2; ++_i) \
        __builtin_amdgcn_global_load_lds((const unsigned*)((const char*)(gbase) + (voff)[_i]), (PG8_LAS unsigned*)(lds + (bufoff) + ldsw + _i * 8192), 16, 0, 0); } while (0)
#define PG8_LDA(dst, b, h) do { _Pragma("unroll") for (int m = 0; m < 4; ++m) _Pragma("unroll") for (int k = 0; k < 2; ++k) dst[m][k] = *(const PG8_LAS bf16x8*)(lds + PG8_SA(b, h) + aoff + m * 2048 + k * 1024); } while (0)
#define PG8_LDB(dst, b, h) do { _Pragma("unroll") for (int n = 0; n < 2; ++n) _Pragma("unroll") for (int k = 0; k < 2; ++k) dst[n][k] = *(const PG8_LAS bf16x8*)(lds + PG8_SB(b, h) + boff + n * 2048 + k * 1024); } while (0)
#define PG8_MMA(ai, bj, At, Bt) do { __builtin_amdgcn_s_setprio(1); _Pragma("unroll") for (int m = 0; m < 4; ++m) _Pragma("unroll") for (int n = 0; n < 2; ++n) _Pragma("unroll") for (int k = 0; k < 2; ++k) \
        acc[ai][bj][m][n] = __builtin_amdgcn_mfma_f32_16x16x32_bf16(Bt[n][k], At[m][k], acc[ai][bj][m][n], 0, 0, 0); __builtin_amdgcn_s_setprio(0); } while (0)
#define PG8_WAIT_V(n) asm volatile("s_waitcnt vmcnt(" #n ")" ::: "memory")
#define PG8_WAIT_L(n) asm volatile("s_waitcnt lgkmcnt(" #n ")" ::: "memory")
#define PG8_BAR __builtin_amdgcn_s_barrier()
#define PG8_SCHED __builtin_amdgcn_sched_barrier(0)
    Unit cur, nxt; int ui = 0;
    if (!S.next(0, cur)) return;
    f32x4 acc[2][2][4][2];
#pragma unroll
    for (int a = 0; a < 2; ++a)
#pragma unroll
        for (int b = 0; b < 2; ++b)
#pragma unroll
            for (int m = 0; m < 4; ++m)
#pragma unroll
                for (int n = 0; n < 2; ++n) acc[a][b][m][n] = (f32x4){0.f, 0.f, 0.f, 0.f};
    bf16x8 At[4][2], B0[2][2], B1[2][2];
    const char* cA = (const char*)g.A + (size_t)cur.pm * tstep; const char* cB = (const char*)g.Bt + (size_t)cur.pn * tstep + S.b_shift(cur);
    S.a_ready(cur);
    if constexpr (SP2) {
        PG8_STAGE(PG8_SB(0, 0), cB, voffB); PG8_STAGE(PG8_SB(0, 1), cB + hstep, voffB); PG8_STAGE(PG8_SA(0, 0), cA, voffA); PG8_STAGE(PG8_SA(0, 1), cA + hstep, voffA);
        if (wr == 1) PG8_BAR;
        PG8_WAIT_V(2); PG8_BAR;
        PG8_STAGE(PG8_SB(1, 0), cB + kstep, voffB); PG8_STAGE(PG8_SA(1, 0), cA + kstep, voffA); PG8_STAGE(PG8_SB(1, 1), cB + hstep + kstep, voffB);
        PG8_WAIT_V(6); PG8_BAR;
    } else {
        PG8_STAGE(PG8_SB(0, 0), cB, voffB); PG8_STAGE(PG8_SA(0, 0), cA, voffA); PG8_STAGE(PG8_SB(0, 1), cB + hstep, voffB); PG8_STAGE(PG8_SA(0, 1), cA + hstep, voffA);
        if (wr == 1) PG8_BAR;
        PG8_WAIT_V(4); PG8_BAR;
        PG8_STAGE(PG8_SB(1, 0), cB + kstep, voffB); PG8_STAGE(PG8_SA(1, 0), cA + kstep, voffA); PG8_STAGE(PG8_SB(1, 1), cB + hstep + kstep, voffB);
        PG8_WAIT_V(6); PG8_BAR;
    }
    for (;;) {
        const bool has_next = S.next(ui + 1, nxt);
        const char* nA = has_next ? (const char*)g.A + (size_t)nxt.pm * tstep : cA; const char* nB = has_next ? (const char*)g.Bt + (size_t)nxt.pn * tstep + S.b_shift(nxt) : cB;
        for (int t = 0; t < nt; t += 2) {
            const bool last = (t == nt - 2);
            const char* a1 = cA + (size_t)(t + 1) * kstep;
            const char* a2 = last ? nA : cA + (size_t)(t + 2) * kstep; const char* b2 = last ? nB : cB + (size_t)(t + 2) * kstep;
            const char* a3 = a2 + kstep; const char* b3 = b2 + kstep;
            if (last && has_next) S.a_ready(nxt);
            if constexpr (SP2) {
            PG8_LDB(B0, 0, 0); PG8_LDB(B1, 0, 1); PG8_SCHED; PG8_LDA(At, 0, 0); PG8_STAGE(PG8_SA(1, 1), a1 + hstep, voffA);
            PG8_WAIT_V(8); PG8_WAIT_L(0); PG8_BAR; PG8_MMA(0, 0, At, B0); PG8_MMA(0, 1, At, B1); PG8_BAR; PG8_SCHED;
            PG8_LDA(At, 0, 1); PG8_STAGE(PG8_SB(0, 0), b2, voffB); PG8_STAGE(PG8_SB(0, 1), b2 + hstep, voffB); PG8_STAGE(PG8_SA(0, 0), a2, voffA);
            PG8_WAIT_V(8); PG8_WAIT_L(0); PG8_BAR; PG8_MMA(1, 0, At, B0); PG8_MMA(1, 1, At, B1); PG8_BAR; PG8_SCHED;
            PG8_LDB(B0, 1, 0); PG8_LDB(B1, 1, 1); PG8_SCHED; PG8_LDA(At, 1, 0); PG8_STAGE(PG8_SA(0, 1), a2 + hstep, voffA);
            PG8_WAIT_V(8); PG8_WAIT_L(0); PG8_BAR; PG8_MMA(0, 0, At, B0); PG8_MMA(0, 1, At, B1); PG8_BAR; PG8_SCHED;
            PG8_LDA(At, 1, 1); PG8_STAGE(PG8_SB(1, 0), b3, voffB); PG8_STAGE(PG8_SB(1, 1), b3 + hstep, voffB); PG8_STAGE(PG8_SA(1, 0), a3, voffA);
            PG8_WAIT_V(8); PG8_WAIT_L(0); PG8_BAR; PG8_MMA(1, 0, At, B0); PG8_MMA(1, 1, At, B1); PG8_BAR; PG8_SCHED;
            } else {
            PG8_LDB(B0, 0, 0); PG8_SCHED; PG8_LDA(At, 0, 0); PG8_STAGE(PG8_SA(1, 1), a1 + hstep, voffA);
            PG8_WAIT_L(8); PG8_BAR; PG8_WAIT_L(0); PG8_MMA(0, 0, At, B0); PG8_BAR; PG8_SCHED;
            PG8_LDB(B1, 0, 1); PG8_STAGE(PG8_SB(0, 0), b2, voffB);
            PG8_BAR; PG8_WAIT_L(0); PG8_MMA(0, 1, At, B1); PG8_BAR;
            PG8_LDA(At, 0, 1); PG8_STAGE(PG8_SA(0, 0), a2, voffA);
            PG8_BAR; PG8_WAIT_L(0); PG8_MMA(1, 0, At, B0); PG8_BAR; PG8_SCHED;
            PG8_STAGE(PG8_SB(0, 1), b2 + hstep, voffB);
            PG8_WAIT_V(6); PG8_BAR; PG8_MMA(1, 1, At, B1); PG8_BAR;
            PG8_LDB(B0, 1, 0); PG8_SCHED; PG8_LDA(At, 1, 0); PG8_STAGE(PG8_SA(0, 1), a2 + hstep, voffA);
            PG8_WAIT_L(8); PG8_BAR; PG8_WAIT_L(0); PG8_MMA(0, 0, At, B0); PG8_BAR; PG8_SCHED;
            PG8_LDB(B1, 1, 1); PG8_STAGE(PG8_SB(1, 0), b3, voffB);
            PG8_BAR; PG8_WAIT_L(0); PG8_MMA(0, 1, At, B1); PG8_BAR;
            PG8_LDA(At, 1, 1); PG8_STAGE(PG8_SA(1, 0), a3, voffA);
            PG8_BAR; PG8_WAIT_L(0); PG8_MMA(1, 0, At, B0); PG8_BAR; PG8_SCHED;
            PG8_STAGE(PG8_SB(1, 1), b3 + hstep, voffB);
            PG8_WAIT_V(6); PG8_BAR; PG8_MMA(1, 1, At, B1); PG8_BAR;
            }
        }
        if constexpr (ALIGN_EPI) { if (wr == 0) PG8_BAR; }
        if constexpr (!Epi::AFTER_DRAIN) { E(acc, cur, wr, wc, fr, fq); S.done(cur); }
        if (!has_next) break;
#pragma unroll
        for (int a = 0; a < 2; ++a)
#pragma unroll
            for (int b = 0; b < 2; ++b)
#pragma unroll
                for (int m = 0; m < 4; ++m)
#pragma unroll
                    for (int n = 0; n < 2; ++n) acc[a][b][m][n] = (f32x4){0.f, 0.f, 0.f, 0.f};
        cur = nxt; cA = nA; cB = nB; ++ui;
        if constexpr (ALIGN_EPI) { if (wr == 1) PG8_BAR; }
    }
    PG8_WAIT_V(0);
    if constexpr (!ALIGN_EPI) { if (wr == 0) PG8_BAR; }
    PG8_BAR;
    if constexpr (Epi::AFTER_DRAIN) { E.fused(acc, cur, wr, wc, fr, fq, lds, wid, lane); S.done(cur); }
#undef PG8_SA
#undef PG8_SB
#undef PG8_STAGE
#undef PG8_LDA
#undef PG8_LDB
#undef PG8_MMA
#undef PG8_WAIT_V
#undef PG8_WAIT_L
#undef PG8_BAR
#undef PG8_SCHED
}
}

#ifndef FOLD
#define FOLD 1
#endif
#ifndef RMERGE
#define RMERGE 1
#endif
#ifndef V4
#define V4 1
#endif
namespace pg8 {
__device__ __forceinline__ float lane_xchg(float v, int src_lane) { return __builtin_bit_cast(float, __builtin_amdgcn_ds_bpermute(src_lane << 2, __builtin_bit_cast(int, v))); }
__device__ __forceinline__ float gelu_tanh_f(float x) {
    const float u2 = 1.5957691216057308f * x * (1.f + 0.044715f * x * x);
    const float e = __builtin_amdgcn_exp2f(-u2 * 1.4426950408889634f);
    return x * __builtin_amdgcn_rcpf(1.f + e);
}
struct EpiProj {
    static constexpr bool PERM = true, AFTER_DRAIN = false;
    bf16_t* O; int ldc; int gelu_tiles; bf16_t* QI; bf16_t* KI;
    __device__ __forceinline__ void operator()(const f32x4 (&acc)[2][2][4][2], const Unit& u, int wr, int wc, int fr, int fq) const {
        const int row0 = u.pm * BM + wr * 64 + fr, col0 = u.pn * BM + wc * 32 + 8 * fq;
        const bool act = u.pn < gelu_tiles;
#pragma unroll
        for (int ai = 0; ai < 2; ++ai)
#pragma unroll
            for (int m = 0; m < 4; ++m) { const int row = row0 + ai * HALF + m * 16; bf16_t* rowp = O + (size_t)row * ldc + col0;
#pragma unroll
                for (int bj = 0; bj < 2; ++bj) { f32x4 v0 = acc[ai][bj][m][0], v1 = acc[ai][bj][m][1];
                    if (act) {
#pragma unroll
                        for (int e = 0; e < 4; ++e) { v0[e] = gelu_tanh_f(v0[e]); v1[e] = gelu_tanh_f(v1[e]); } }
                    u32x4 w; w.x = cvt_pk_bf16(v0[0], v0[1]); w.y = cvt_pk_bf16(v0[2], v0[3]); w.z = cvt_pk_bf16(v1[0], v1[1]); w.w = cvt_pk_bf16(v1[2], v1[3]);
                    if (u.pn < 4) *(u32x4*)(rowp + bj * HALF) = w;
                    else { const int c = col0 + bj * HALF - 1024; const int isk = c >> 9, hd = (c >> 6) & 7, dch = (c >> 3) & 7; const int pos = row & 31;
                        const int p2 = isk ? ((pos & ~12) | ((pos & 4) << 1) | ((pos & 8) >> 1)) : pos;
                        const size_t cell = ((((size_t)(row >> 5) * 8 + hd) * 4 + (dch >> 1)) * 2 + (dch & 1)) * 32 + p2;
                        *(u32x4*)((isk ? KI : QI) + cell * 8) = w; } } }
    }
};
struct EpiResid {
    static constexpr bool PERM = true, AFTER_DRAIN = false;
    const float* xin_f; const bf16_t* xin_h; bf16_t* xout; const float* gt; float* SS;
    __device__ __forceinline__ void operator()(const f32x4 (&acc)[2][2][4][2], const Unit& u, int wr, int wc, int fr, int fq) const {
        const int row0 = u.pm * BM + wr * 64 + fr, col0 = u.pn * BM + wc * 32 + 8 * fq;
        const int b = (u.pm * BM) >> 11;
        f32x4 g[2][2];
        float psq[2][4];
#pragma unroll
        for (int ai = 0; ai < 2; ++ai)
#pragma unroll
            for (int m = 0; m < 4; ++m) psq[ai][m] = 0.f;
#pragma unroll
        for (int bj = 0; bj < 2; ++bj)
#pragma unroll
            for (int n = 0; n < 2; ++n) g[bj][n] = *(const f32x4*)(gt + (size_t)b * 6144 + col0 + bj * HALF + 4 * n);
#pragma unroll
        for (int ai = 0; ai < 2; ++ai)
#pragma unroll
            for (int m = 0; m < 4; ++m) { const size_t ro = (size_t)(row0 + ai * HALF + m * 16) * 1024 + col0;
#pragma unroll
                for (int bj = 0; bj < 2; ++bj) { const size_t o = ro + bj * HALF; f32x4 x0, x1;
                    if (xin_f) { x0 = *(const f32x4*)(xin_f + o); x1 = *(const f32x4*)(xin_f + o + 4); }
                    else { const u32x4 w = *(const u32x4*)(xin_h + o);
                        x0 = (f32x4){__builtin_bit_cast(float, w.x << 16), __builtin_bit_cast(float, w.x & 0xffff0000u), __builtin_bit_cast(float, w.y << 16), __builtin_bit_cast(float, w.y & 0xffff0000u)};
                        x1 = (f32x4){__builtin_bit_cast(float, w.z << 16), __builtin_bit_cast(float, w.z & 0xffff0000u), __builtin_bit_cast(float, w.w << 16), __builtin_bit_cast(float, w.w & 0xffff0000u)}; }
                    const f32x4 v0 = x0 + g[bj][0] * acc[ai][bj][m][0], v1 = x1 + g[bj][1] * acc[ai][bj][m][1];
                    { const f32x4 q0 = v0 * v0, q1 = v1 * v1; psq[ai][m] += ((q0[0] + q0[1]) + (q0[2] + q0[3])) + ((q1[0] + q1[1]) + (q1[2] + q1[3])); }
                    u32x4 w; w.x = cvt_pk_bf16(v0[0], v0[1]); w.y = cvt_pk_bf16(v0[2], v0[3]); w.z = cvt_pk_bf16(v1[0], v1[1]); w.w = cvt_pk_bf16(v1[2], v1[3]);
                    *(u32x4*)(xout + o) = w; } }
        if (SS) { const int ln = fr + 16 * fq;
#pragma unroll
            for (int ai = 0; ai < 2; ++ai)
#pragma unroll
                for (int m = 0; m < 4; ++m) { float sq = psq[ai][m]; sq += lane_xchg(sq, ln ^ 16); sq += lane_xchg(sq, ln ^ 32);
                    if (fq == 0) SS[(size_t)(row0 + ai * HALF + m * 16) * 16 + u.pn * 4 + wc] = sq; } }
    }
};
struct EpiQ {
    static constexpr bool PERM = true, AFTER_DRAIN = false;
    bf16_t* O; const float* SS; const float* cvec;
    __device__ __forceinline__ void operator()(const f32x4 (&acc)[2][2][4][2], const Unit& u, int wr, int wc, int fr, int fq) const {
        const int row0 = u.pm * BM + wr * 64 + fr, col0 = u.pn * BM + wc * 32 + 8 * fq;
        const int b = (u.pm * BM) >> 11, ln = fr + 16 * fq;
        f32x4 cv[2][2];
#pragma unroll
        for (int bj = 0; bj < 2; ++bj)
#pragma unroll
            for (int n = 0; n < 2; ++n) cv[bj][n] = *(const f32x4*)(cvec + (size_t)b * 1024 + col0 + bj * HALF + 4 * n);
#pragma unroll
        for (int ai = 0; ai < 2; ++ai)
#pragma unroll
            for (int m = 0; m < 4; ++m) { const int row = row0 + ai * HALF + m * 16;
                const f32x4 pv = *(const f32x4*)(SS + (size_t)row * 16 + 4 * fq);
                float sq = (pv[0] + pv[1]) + (pv[2] + pv[3]); sq += lane_xchg(sq, ln ^ 16); sq += lane_xchg(sq, ln ^ 32);
                const float rs = __builtin_amdgcn_rsqf(sq * (1.f / 1024.f) + 1e-6f);
                bf16_t* rowp = O + (size_t)row * 1024 + col0;
#pragma unroll
                for (int bj = 0; bj < 2; ++bj) { const f32x4 v0 = acc[ai][bj][m][0] * rs + cv[bj][0], v1 = acc[ai][bj][m][1] * rs + cv[bj][1];
                    u32x4 w; w.x = cvt_pk_bf16(v0[0], v0[1]); w.y = cvt_pk_bf16(v0[2], v0[3]); w.z = cvt_pk_bf16(v1[0], v1[1]); w.w = cvt_pk_bf16(v1[2], v1[3]);
                    *(u32x4*)(rowp + bj * HALF) = w; } }
    }
};
struct EpiVT {
    static constexpr bool PERM = true, AFTER_DRAIN = false;
    bf16_t* O;
    __device__ __forceinline__ void operator()(const f32x4 (&acc)[2][2][4][2], const Unit& u, int wr, int wc, int fr, int fq) const {
        const int row0 = u.pm * BM + wr * 64 + fr, col0 = u.pn * BM + wc * 32 + 8 * fq;
#pragma unroll
        for (int ai = 0; ai < 2; ++ai)
#pragma unroll
            for (int m = 0; m < 4; ++m) { const int ch = row0 + ai * HALF + m * 16;
#pragma unroll
                for (int bj = 0; bj < 2; ++bj) { const f32x4 v0 = acc[ai][bj][m][0], v1 = acc[ai][bj][m][1];
                    u32x4 w; w.x = cvt_pk_bf16(v0[0], v0[1]); w.y = cvt_pk_bf16(v0[2], v0[3]); w.z = cvt_pk_bf16(v1[0], v1[1]); w.w = cvt_pk_bf16(v1[2], v1[3]);
                    const int tc = (col0 + bj * HALF) >> 3;
                    *(u32x4*)(O + ((size_t)tc * 512 + ch) * 8) = w; } }
    }
};
}

namespace mk {
#define GAS __attribute__((address_space(1)))
#define LAS __attribute__((address_space(3)))
typedef unsigned short bf16;
typedef unsigned v4u __attribute__((ext_vector_type(4)));
typedef unsigned v2u __attribute__((ext_vector_type(2)));
typedef int v4i __attribute__((ext_vector_type(4)));
typedef float f32x2 __attribute__((ext_vector_type(2)));
typedef float f32x4 __attribute__((ext_vector_type(4)));
typedef float f32x16 __attribute__((ext_vector_type(16)));
typedef short bf16x8 __attribute__((ext_vector_type(8)));
typedef short s16x4 __attribute__((ext_vector_type(4)));

constexpr int NWAVES = 8, NTHR = 512;
constexpr int BATCH = 16, SEQ = 2048, NT = BATCH * SEQ, DM = 1024, PCM = 2048, PCALL = 2560, MODW = 6144;
constexpr int PUV = 1024;
constexpr int NEXP = 16384;
constexpr int TROW = 1024;
constexpr int TROWV = TROW;
constexpr float EPSF = 1e-6f;
constexpr float STICK_T = 30.f;
constexpr size_t MiB = 1u << 20;
constexpr size_t WS_CTL = 0, CTL_ZERO_BYTES = 1 * MiB;
constexpr size_t WS_MOD = 1 * MiB;
constexpr size_t WS_WIN = 2 * MiB;
constexpr size_t WS_WOUT = 12 * MiB;
constexpr size_t WS_WQ = 16 * MiB;
constexpr size_t WS_SGU = 20 * MiB;
constexpr size_t WS_K12 = 20 * MiB + 512 * 1024;
constexpr size_t WS_SCL = 21 * MiB;
constexpr size_t WS_CHK = 21 * MiB + 512 * 1024;
constexpr size_t WS_U8 = 22 * MiB;
constexpr size_t WS_V8 = 54 * MiB;
constexpr size_t WS_XRES = 86 * MiB;
constexpr size_t WS_QI = 150 * MiB;
constexpr size_t WS_KI = 182 * MiB;
constexpr size_t WS_HB = 214 * MiB;
constexpr size_t WS_PROJ = 278 * MiB;
constexpr size_t WS_VT = 406 * MiB;
constexpr size_t WS_YMIX = 438 * MiB;
constexpr size_t WS_END = 511 * MiB;
constexpr size_t WS_WQS = 342 * MiB;
constexpr size_t WS_SS = WS_QI;
constexpr size_t WS_GS = 20 * MiB + 640 * 1024;
constexpr size_t WS_CVEC = 20 * MiB + 768 * 1024;
constexpr int CW_BAR = 4096;

constexpr int RING_BYTES = 131072, LDSCTL_OFF = RING_BYTES, MISC_OFF = LDSCTL_OFF + 320, LDS_BYTES = 147456;

__device__ __forceinline__ unsigned f2bf(float f) { unsigned u = __builtin_bit_cast(unsigned, f); return (u + 0x7fffu + ((u >> 16) & 1u)) >> 16; }
__device__ __forceinline__ unsigned pk2(float lo, float hi) { return f2bf(lo) | (f2bf(hi) << 16); }
__device__ __forceinline__ float bf2f(unsigned short b) { return __builtin_bit_cast(float, (unsigned)b << 16); }
__device__ __forceinline__ float bflo(unsigned w) { return __builtin_bit_cast(float, w << 16); }
__device__ __forceinline__ float bfhi(unsigned w) { return __builtin_bit_cast(float, w & 0xffff0000u); }
#ifndef RES_BF16
#define RES_BF16 1
#endif
typedef bf16 res_t;
__device__ __forceinline__ f32x4 ld4(const float* row, int i) { return ((const f32x4*)row)[i]; }
__device__ __forceinline__ f32x4 ld4(const bf16* row, int i) { const v2u w = ((const v2u*)row)[i]; return (f32x4){bflo(w.x), bfhi(w.x), bflo(w.y), bfhi(w.y)}; }
__device__ __forceinline__ void st4(float* row, int i, f32x4 v) { ((f32x4*)row)[i] = v; }
__device__ __forceinline__ void st4(bf16* row, int i, f32x4 v) { v2u w; w.x = pk2(v.x, v.y); w.y = pk2(v.z, v.w); ((v2u*)row)[i] = w; }
__device__ __forceinline__ int lane_now() { int l = (int)__builtin_amdgcn_mbcnt_hi(~0u, __builtin_amdgcn_mbcnt_lo(~0u, 0u)); asm volatile("" : "+v"(l)); return l; }
__device__ __forceinline__ float shx(float v, int k) { return __builtin_bit_cast(float, __builtin_amdgcn_ds_bpermute((lane_now() ^ k) << 2, __builtin_bit_cast(int, v))); }
__device__ __forceinline__ int shi(int v, int src) { return __builtin_amdgcn_ds_bpermute(src << 2, v); }
__device__ __forceinline__ float shf(float v, int src) { return __builtin_bit_cast(float, __builtin_amdgcn_ds_bpermute(src << 2, __builtin_bit_cast(int, v))); }
__device__ __forceinline__ float wave_sum(float v) {
#pragma unroll
    for (int o = 1; o < 64; o <<= 1) v += shx(v, o);
    return v;
}
__device__ __forceinline__ float wave_max(float v) {
#pragma unroll
    for (int o = 1; o < 64; o <<= 1) v = fmaxf(v, shx(v, o));
    return v;
}
__device__ __forceinline__ float silu_f(float x) { return x / (1.f + __expf(-x)); }
__device__ __forceinline__ float softplus_fast(float z) {
    const float e = __builtin_amdgcn_exp2f(-fabsf(z) * 1.4426950408889634f);
    return fmaxf(z, 0.f) + __builtin_amdgcn_logf(1.f + e) * 0.6931471805599453f;
}
__device__ __forceinline__ float exp_fast(float x) { return __builtin_amdgcn_exp2f(x * 1.4426950408889634f); }

#define XB_TMO      128
#define XB_XCNT(j)  (256  + 64 * (j))
#define XB_XSUB(j)  (1280 + 64 * (j))
#define XB_XGEN(j)  (2304 + 64 * (j))
#define XB_TOP      3328
#define XB_TOPGEN   3392
#define XCD_BAR_WORDS 3456
#define XB_SPIN_CAP (1u << 18)

__device__ __forceinline__ unsigned xb_ld(unsigned* p)              { return __hip_atomic_load(p, __ATOMIC_RELAXED, __HIP_MEMORY_SCOPE_AGENT); }
__device__ __forceinline__ unsigned xb_add(unsigned* p, unsigned v) { return __hip_atomic_fetch_add(p, v, __ATOMIC_RELAXED, __HIP_MEMORY_SCOPE_AGENT); }
__device__ __forceinline__ unsigned xb_xcc_id() { return (unsigned)__builtin_amdgcn_s_getreg((3 << 11) | 20) & 0xFu; }
#define XB_SPIN(cond, bar) do { unsigned _sp = 0; while (cond) { __builtin_amdgcn_s_sleep(1); \
    if ((++_sp & 255u) == 0u) { if (xb_ld(&(bar)[XB_TMO])) break; if (_sp > XB_SPIN_CAP) { atomicAdd(&(bar)[XB_TMO], 1u); break; } } } } while (0)

struct XcdBarrier {
    unsigned* bar; unsigned x;
    volatile LAS unsigned* st;
};

__device__ __forceinline__ XcdBarrier xcd_barrier_post(unsigned* bar, volatile LAS unsigned* st) {
    XcdBarrier b; b.bar = bar; b.x = xb_xcc_id(); b.st = st;
    if (threadIdx.x == 0) (void)xb_add(&bar[XB_XCNT(b.x)], 1u);
    return b;
}
__device__ __forceinline__ void xcd_barrier_complete(unsigned* bar, unsigned x, unsigned& nloc, unsigned& nx) {
    const unsigned G = gridDim.x * gridDim.y * gridDim.z;
    unsigned sum, cnt, mine, sp = 0u;
    for (;;) {
        sum = 0u; cnt = 0u; mine = 0u;
#pragma unroll
        for (unsigned j = 0; j < 16; ++j) { const unsigned c = xb_ld(&bar[XB_XCNT(j)]); sum += c; cnt += (c > 0u) ? 1u : 0u; mine = (j == x) ? c : mine; }
        if (sum == G) break;
        __builtin_amdgcn_s_sleep(1);
        if ((++sp & 255u) == 0u) { if (xb_ld(&bar[XB_TMO])) break; if (sp > XB_SPIN_CAP) { atomicAdd(&bar[XB_TMO], 1u); break; } }
    }
    nloc = mine > 0u ? mine : 1u; nx = cnt > 0u ? cnt : 1u;
}

__device__ __forceinline__ void xcd_barrier(const XcdBarrier& b) {
    asm volatile("s_waitcnt vmcnt(0)" ::: "memory");
    __syncthreads();
    if (threadIdx.x == 0) {
        unsigned* bar = b.bar;
        __builtin_amdgcn_s_waitcnt(0);
        unsigned nloc = b.st[0], nx = b.st[1];
        if (nloc == 0u) { xcd_barrier_complete(bar, b.x, nloc, nx); b.st[0] = nloc; b.st[1] = nx; }
        const unsigned old = xb_add(&bar[XB_XSUB(b.x)], 1u);
        const unsigned gen = old / nloc;
        if (old + 1u == (gen + 1u) * nloc) {
            __builtin_amdgcn_fence(__ATOMIC_RELEASE, "agent");
            asm volatile("s_waitcnt vmcnt(0)" ::: "memory");
            const unsigned og = xb_add(&bar[XB_TOP], 1u);
            const unsigned tg = og / nx;
            if (og + 1u == (tg + 1u) * nx) xb_add(&bar[XB_TOPGEN], 1u);
            else XB_SPIN(xb_ld(&bar[XB_TOPGEN]) == tg, bar);
            __builtin_amdgcn_fence(__ATOMIC_ACQUIRE, "agent");
            xb_add(&bar[XB_XGEN(b.x)], 1u);
            asm volatile("s_waitcnt vmcnt(0)" ::: "memory");
        } else {
            XB_SPIN(xb_ld(&bar[XB_XGEN(b.x)]) == gen, bar);
            __builtin_amdgcn_fence(__ATOMIC_ACQUIRE, "agent");
            asm volatile("s_waitcnt vmcnt(0)" ::: "memory");
        }
    }
    __syncthreads();
}

struct Ctx {
    LAS unsigned char* lds;
    int tid, lane, wave, G, vcu, gw, NGW;
    unsigned char* ws;
};

__device__ __forceinline__ void p0_transpose_item(const float* W, int K, int N, bf16* WT, LAS float* scr, int item, int lane) {
    const int nblk = N / 32, kb = item / nblk, nb = item % nblk, k0 = 64 * kb, n0 = 32 * nb;
#pragma unroll 8
    for (int i = 0; i < 32; ++i) { const int kk = 2 * i + (lane >> 5); scr[kk * 33 + (lane & 31)] = W[(size_t)(k0 + kk) * N + n0 + (lane & 31)]; }
    asm volatile("s_waitcnt lgkmcnt(0)" ::: "memory");
    const int c = lane & 7;
#pragma unroll
    for (int j = 0; j < 4; ++j) { const int n = (lane >> 3) + 8 * j; const LAS float* s = scr + (8 * c) * 33 + n;
        v4u o; o.x = pk2(s[0 * 33], s[1 * 33]); o.y = pk2(s[2 * 33], s[3 * 33]); o.z = pk2(s[4 * 33], s[5 * 33]); o.w = pk2(s[6 * 33], s[7 * 33]);
        *(v4u*)(WT + (size_t)(n0 + n) * K + k0 + 8 * c) = o; }
    asm volatile("s_waitcnt lgkmcnt(0)" ::: "memory");
}

template <class TI> __device__ __forceinline__ void norm_row_bf16(const TI* xrow, const float* g, const float* sh, const float* sc, bf16* orow, int lane) {
    f32x4 v[4]; float ss = 0.f;
#pragma unroll
    for (int j = 0; j < 4; ++j) { v[j] = ld4(xrow, lane + 64 * j); ss += (v[j].x * v[j].x + v[j].y * v[j].y) + (v[j].z * v[j].z + v[j].w * v[j].w); }
    const float rs = rsqrtf(wave_sum(ss) * (1.f / DM) + EPSF);
#pragma unroll
    for (int j = 0; j < 4; ++j) {
        const f32x4 gg = ((const f32x4*)g)[lane + 64 * j], s1 = ((const f32x4*)sc)[lane + 64 * j], s0 = ((const f32x4*)sh)[lane + 64 * j];
        const f32x4 o = v[j] * rs * gg * (s1 + 1.f) + s0;
        v2u w; w.x = pk2(o.x, o.y); w.y = pk2(o.z, o.w);
        ((v2u*)orow)[lane + 64 * j] = w;
    }
}

template <class TI> __device__ __forceinline__ void norm_rows2_bf16(const TI* xa, const TI* xb, const float* g, const float* sha, const float* sca, const float* shb, const float* scb, bf16* oa, bf16* ob, int lane) {
    f32x4 va[4], vb[4]; float sa = 0.f, sb = 0.f;
#pragma unroll
    for (int j = 0; j < 4; ++j) { va[j] = ld4(xa, lane + 64 * j); vb[j] = ld4(xb, lane + 64 * j); }
#pragma unroll
    for (int j = 0; j < 4; ++j) { sa += (va[j].x * va[j].x + va[j].y * va[j].y) + (va[j].z * va[j].z + va[j].w * va[j].w); sb += (vb[j].x * vb[j].x + vb[j].y * vb[j].y) + (vb[j].z * vb[j].z + vb[j].w * vb[j].w); }
#pragma unroll
    for (int o = 1; o < 64; o <<= 1) { sa += shx(sa, o); sb += shx(sb, o); }
    const float ra = rsqrtf(sa * (1.f / DM) + EPSF), rb = rsqrtf(sb * (1.f / DM) + EPSF);
#pragma unroll
    for (int j = 0; j < 4; ++j) {
        const f32x4 gg = ((const f32x4*)g)[lane + 64 * j];
        { const f32x4 s1 = ((const f32x4*)sca)[lane + 64 * j], s0 = ((const f32x4*)sha)[lane + 64 * j]; const f32x4 o = va[j] * ra * gg * (s1 + 1.f) + s0; v2u w; w.x = pk2(o.x, o.y); w.y = pk2(o.z, o.w); ((v2u*)oa)[lane + 64 * j] = w; }
        { const f32x4 s1 = ((const f32x4*)scb)[lane + 64 * j], s0 = ((const f32x4*)shb)[lane + 64 * j]; const f32x4 o = vb[j] * rb * gg * (s1 + 1.f) + s0; v2u w; w.x = pk2(o.x, o.y); w.y = pk2(o.z, o.w); ((v2u*)ob)[lane + 64 * j] = w; }
    }
}

__device__ __forceinline__ void table_row_i8(const float* src, unsigned char* dst, float* inv_scale, int lane) {
    f32x4 v[4]; float mx = 0.f;
#pragma unroll
    for (int j = 0; j < 4; ++j) { v[j] = ((const f32x4*)src)[lane + 64 * j]; mx = fmaxf(mx, fmaxf(fmaxf(fabsf(v[j].x), fabsf(v[j].y)), fmaxf(fabsf(v[j].z), fabsf(v[j].w)))); }
    mx = wave_max(mx);
    const float scale = (mx > 1e-30f) ? 127.f / mx : 0.f, inv = (mx > 1e-30f) ? mx * (1.f / 127.f) : 0.f;
    v4u o;
#pragma unroll
    for (int j = 0; j < 4; ++j) {
        const int a = (int)rintf(v[j].x * scale), b = (int)rintf(v[j].y * scale), c = (int)rintf(v[j].z * scale), d = (int)rintf(v[j].w * scale);
        o[j] = ((unsigned)a & 255u) | (((unsigned)b & 255u) << 8) | (((unsigned)c & 255u) << 16) | (((unsigned)d & 255u) << 24); }
    ((v4u*)dst)[lane] = o;
    if (lane == 0) *inv_scale = inv;
}
__device__ __forceinline__ void table_row_i4(const float* src, unsigned char* dst, float* inv_scale, int lane) {
    f32x4 v[4]; float mx = 0.f;
#pragma unroll
    for (int j = 0; j < 4; ++j) { v[j] = ((const f32x4*)src)[lane + 64 * j]; mx = fmaxf(mx, fmaxf(fmaxf(fabsf(v[j].x), fabsf(v[j].y)), fmaxf(fabsf(v[j].z), fabsf(v[j].w)))); }
    mx = wave_max(mx);
    const float scale = (mx > 1e-30f) ? 7.f / mx : 0.f, inv = (mx > 1e-30f) ? mx * (1.f / 7.f) : 0.f;
    v2u o;
#pragma unroll
    for (int c = 0; c < 2; ++c) { unsigned w = 0;
#pragma unroll
        for (int i = 0; i < 4; ++i) { const int ql = (int)rintf(v[2 * c][i] * scale), qh = (int)rintf(v[2 * c + 1][i] * scale);
            w |= ((((unsigned)qh & 15u) << 4) | ((unsigned)(ql + 8) & 15u)) << (8 * i); }
        o[c] = w; }
    ((v2u*)dst)[lane] = o;
    if (lane == 0) *inv_scale = inv;
}

__device__ __forceinline__ bf16x8 pack8(const float* a) {
    v4u w; w.x = pk2(a[0], a[1]); w.y = pk2(a[2], a[3]); w.z = pk2(a[4], a[5]); w.w = pk2(a[6], a[7]);
    return __builtin_bit_cast(bf16x8, w);
}
__device__ __forceinline__ void attn_item(const bf16* QI, const bf16* KI, const bf16* VT, bf16* YMIX, const float* onb, int b, int hd, int qb, int lane) {
    const int n = lane & 31, h = lane >> 5;
    const size_t rowbase = (size_t)b * SEQ;
    const int t0 = qb * 32;
    bf16x8 qf[4];
    { const bf16* qp = QI + (((size_t)((rowbase + t0) >> 5) * 8 + hd) * 8 + h) * 256 + n * 8;
#pragma unroll
      for (int ks = 0; ks < 4; ++ks) qf[ks] = *(const bf16x8*)(qp + ks * 512); }
    const bf16* kbase = KI + (((size_t)(rowbase >> 5) * 8 + hd) * 8 + h) * 256 + n * 8;
    const bf16* vbase = VT + ((size_t)(rowbase >> 3) * 512 + hd * 64 + n) * 8 + (size_t)h * 512 * 8;
    f32x16 o0, o1;
#pragma unroll
    for (int i = 0; i < 16; ++i) { o0[i] = 0.f; o1[i] = 0.f; }
    float R = 0.f;
#define ATT_LOAD(kf_, va0_, va1_, j_) do { const bf16* kp_ = kbase + (size_t)(j_) * 16384; const bf16* vp_ = vbase + (size_t)(4 * (j_)) * 4096; \
        _Pragma("unroll") for (int ks = 0; ks < 4; ++ks) kf_[ks] = *(const bf16x8*)(kp_ + ks * 512); \
        _Pragma("unroll") for (int s_ = 0; s_ < 2; ++s_) { va0_[s_] = *(const bf16x8*)(vp_ + (size_t)(2 * s_) * 4096); va1_[s_] = *(const bf16x8*)(vp_ + (size_t)(2 * s_) * 4096 + 256); } } while (0)
#define ATT_BLOCK(kf_, va0_, va1_, j_) do { \
        f32x16 sacc; _Pragma("unroll") for (int i = 0; i < 16; ++i) sacc[i] = 0.f; \
        _Pragma("unroll") for (int ks = 0; ks < 4; ++ks) sacc = __builtin_amdgcn_mfma_f32_32x32x16_bf16(kf_[ks], qf[ks], sacc, 0, 0, 0); \
        const bool diag = ((j_) == qb); float sp[16], zz[16]; \
        _Pragma("unroll") for (int i = 0; i < 16; ++i) { const float z = sacc[i] * 0.125f; const int key = (i & 7) + 8 * h + 16 * (i >> 3); const bool valid = (!diag) || (key < n); \
            const float s_ = softplus_fast(z); sp[i] = valid ? s_ : 0.f; zz[i] = z; } \
        float g0_ = 0.f, g1_ = 0.f; _Pragma("unroll") for (int i = 0; i < 8; ++i) { g0_ += sp[i]; g1_ += sp[8 + i]; } \
        const float p0_ = shx(g0_, 32), p1_ = shx(g1_, 32); \
        float a[16]; \
        { float suf = (h == 0 ? p1_ : 0.f);                                     \
          _Pragma("unroll") for (int e = 7; e >= 0; --e) { const int i = 8 + e; const int key = e + 8 * h + 16; const bool valid = (!diag) || (key < n); \
              a[i] = valid ? exp_fast((zz[i] - sp[i]) + (R - suf)) : 0.f; suf += sp[i]; } } \
        { float suf = (h == 0 ? p0_ : 0.f) + g1_ + p1_;                         \
          _Pragma("unroll") for (int e = 7; e >= 0; --e) { const int i = e; const int key = e + 8 * h; const bool valid = (!diag) || (key < n); \
              a[i] = valid ? exp_fast((zz[i] - sp[i]) + (R - suf)) : 0.f; suf += sp[i]; } } \
        R -= (g0_ + p0_) + (g1_ + p1_); \
        const bf16x8 pf0 = pack8(a), pf1 = pack8(a + 8); \
        o0 = __builtin_amdgcn_mfma_f32_32x32x16_bf16(va0_[0], pf0, o0, 0, 0, 0); \
        o0 = __builtin_amdgcn_mfma_f32_32x32x16_bf16(va0_[1], pf1, o0, 0, 0, 0); \
        o1 = __builtin_amdgcn_mfma_f32_32x32x16_bf16(va1_[0], pf0, o1, 0, 0, 0); \
        o1 = __builtin_amdgcn_mfma_f32_32x32x16_bf16(va1_[1], pf1, o1, 0, 0, 0); } while (0)
    { bf16x8 kA[4], kB[4]; bf16x8 vA0[2], vA1[2], vB0[2], vB1[2];
      int j = qb;
      ATT_LOAD(kA, vA0, vA1, j);
      for (;;) {
          ATT_LOAD(kB, vB0, vB1, (j > 0 ? j - 1 : 0));
          ATT_BLOCK(kA, vA0, vA1, j);
          if (j == 0 || __all(R < -STICK_T)) break;
          --j;
          ATT_LOAD(kA, vA0, vA1, (j > 0 ? j - 1 : 0));
          ATT_BLOCK(kB, vB0, vB1, j);
          if (j == 0 || __all(R < -STICK_T)) break;
          --j;
      } }
#undef ATT_LOAD
#undef ATT_BLOCK
    float ss = 0.f;
#pragma unroll
    for (int i = 0; i < 16; ++i) ss += o0[i] * o0[i] + o1[i] * o1[i];
    ss += shx(ss, 32);
    const float rs = rsqrtf(ss * (1.f / 64.f) + EPSF);
    bf16* yp = YMIX + (rowbase + t0 + n) * DM + 512 + hd * 64 + 4 * h;
    const float* gp = onb + hd * 64 + 4 * h;
#pragma unroll
    for (int q = 0; q < 4; ++q) {
        const f32x4 g0 = *(const f32x4*)(gp + 8 * q), g1 = *(const f32x4*)(gp + 32 + 8 * q);
        v2u w0, w1;
        w0.x = pk2(o0[4 * q] * rs * g0.x, o0[4 * q + 1] * rs * g0.y); w0.y = pk2(o0[4 * q + 2] * rs * g0.z, o0[4 * q + 3] * rs * g0.w);
        w1.x = pk2(o1[4 * q] * rs * g1.x, o1[4 * q + 1] * rs * g1.y); w1.y = pk2(o1[4 * q + 2] * rs * g1.z, o1[4 * q + 3] * rs * g1.w);
        *(v2u*)(yp + 8 * q) = w0; *(v2u*)(yp + 32 + 8 * q) = w1;
    }
}

__device__ __forceinline__ void gmlp_unit(const Ctx& C, const bf16* PROJ, const bf16* SGUW_l, const float* bs_l, const float* ona_l, bf16* YMIX, int b, int c, int g,
                                          v4u r0, v4u r1, const bf16* next_vp, v4u& nr0, v4u& nr1) {
    const size_t R0 = (size_t)b * SEQ + c * 128;
    LAS unsigned short* vnT = (LAS unsigned short*)C.lds;
    LAS float* ssum = (LAS float*)(C.lds + 64 * 272);
    const int mb = C.wave & 1, tb = C.wave >> 1, n = C.lane & 31, h = C.lane >> 5;
    const int tt = C.tid >> 2, qd = C.tid & 3;
    const bf16* wp = SGUW_l + ((size_t)g * 128 + 32 * tb + n) * 128 + 8 * h;
    bf16x8 wf[8];
#pragma unroll
    for (int ks = 0; ks < 8; ++ks) wf[ks] = *(const bf16x8*)(wp + 16 * ks);
    const float bb = bs_l[g * 128 + 32 * tb + n];
    const bf16* up = PROJ + (R0 + 32 * tb + n) * PUV + g * 64 + 32 * mb + 4 * h;
    v2u uu[4];
#pragma unroll
    for (int q = 0; q < 4; ++q) uu[q] = *(const v2u*)(up + 8 * q);
    const float* op = ona_l + g * 64 + 32 * mb + 4 * h;
    f32x4 gg[4];
#pragma unroll
    for (int q = 0; q < 4; ++q) gg[q] = *(const f32x4*)(op + 8 * q);
    { float v[16];
#pragma unroll
      for (int e = 0; e < 4; ++e) { v[2 * e] = bflo(r0[e]); v[2 * e + 1] = bfhi(r0[e]); v[8 + 2 * e] = bflo(r1[e]); v[8 + 2 * e + 1] = bfhi(r1[e]); }
      nr0 = *(const v4u*)next_vp; nr1 = *(const v4u*)(next_vp + 8);
      float s = 0.f;
#pragma unroll
      for (int e = 0; e < 16; ++e) s += v[e];
      s += shx(s, 1); s += shx(s, 2);
      const float mu = s * (1.f / 64.f);
      float q = 0.f;
#pragma unroll
      for (int e = 0; e < 16; ++e) { const float d = v[e] - mu; q += d * d; }
      q += shx(q, 1); q += shx(q, 2);
      const float rstd = rsqrtf(q * (1.f / 64.f) + EPSF);
#pragma unroll
      for (int e = 0; e < 16; ++e) vnT[(16 * qd + e) * 136 + tt] = (unsigned short)f2bf((v[e] - mu) * rstd);
    }
    __syncthreads();
    f32x16 acc;
#pragma unroll
    for (int i = 0; i < 16; ++i) acc[i] = 0.f;
    const LAS unsigned char* ap = C.lds + (32 * mb + n) * 272 + 16 * h;
#pragma unroll
    for (int ks = 0; ks < 8; ++ks) {
        const bf16x8 af = *(const LAS bf16x8*)(ap + 32 * ks);
        acc = __builtin_amdgcn_mfma_f32_32x32x16_bf16(af, wf[ks], acc, 0, 0, 0);
    }
    float y[16]; float ss = 0.f;
#pragma unroll
    for (int q = 0; q < 4; ++q) {
        const float u0 = bflo(uu[q].x), u1 = bfhi(uu[q].x), u2 = bflo(uu[q].y), u3 = bfhi(uu[q].y);
        y[4 * q] = u0 * (acc[4 * q] + bb); y[4 * q + 1] = u1 * (acc[4 * q + 1] + bb); y[4 * q + 2] = u2 * (acc[4 * q + 2] + bb); y[4 * q + 3] = u3 * (acc[4 * q + 3] + bb);
#pragma unroll
        for (int e = 0; e < 4; ++e) ss += y[4 * q + e] * y[4 * q + e]; }
    ss += shx(ss, 32);
    if (h == 0) ssum[mb * 128 + 32 * tb + n] = ss;
    __syncthreads();
    const float tot = ssum[32 * tb + n] + ssum[128 + 32 * tb + n];
    const float rs = rsqrtf(tot * (1.f / 64.f) + EPSF);
    bf16* yp = YMIX + (R0 + 32 * tb + n) * DM + g * 64 + 32 * mb + 4 * h;
#pragma unroll
    for (int q = 0; q < 4; ++q) {
        v2u w; w.x = pk2(y[4 * q] * rs * gg[q].x, y[4 * q + 1] * rs * gg[q].y); w.y = pk2(y[4 * q + 2] * rs * gg[q].z, y[4 * q + 3] * rs * gg[q].w);
        *(v2u*)(yp + 8 * q) = w; }
}

__device__ __forceinline__ void gmlp_phase(const Ctx& C, const bf16* PROJ, const bf16* SGUW_l, const float* bs_l, const float* ona_l, bf16* YMIX) {
    constexpr int NU = BATCH * 16 * 8;
    if ((int)blockIdx.x >= NU) return;
    LAS unsigned short* vnT = (LAS unsigned short*)C.lds;
    LAS float* ssum = (LAS float*)(C.lds + 64 * 272);
    const int mb = C.wave & 1, tb = C.wave >> 1, n = C.lane & 31, h = C.lane >> 5;
    const int tt = C.tid >> 2, qd = C.tid & 3;
    auto vptr = [&](int u) { const int g = u & 7, c = (u >> 3) & 15, b = u >> 7; return PROJ + ((size_t)b * SEQ + c * 128 + tt) * PUV + 512 + g * 64 + 16 * qd; };
    auto uptr = [&](int u) { const int g = u & 7, c = (u >> 3) & 15, b = u >> 7; return PROJ + ((size_t)b * SEQ + c * 128 + 32 * tb + n) * PUV + g * 64 + 32 * mb + 4 * h; };
    int u = blockIdx.x, g_cur = u & 7;
    bf16x8 wf[8]; float bb; f32x4 gg[4];
#define GMLP_LOAD_G(g_) do { const bf16* wp_ = SGUW_l + ((size_t)(g_) * 128 + 32 * tb + n) * 128 + 8 * h; \
        _Pragma("unroll") for (int ks = 0; ks < 8; ++ks) wf[ks] = *(const bf16x8*)(wp_ + 16 * ks); \
        bb = bs_l[(g_) * 128 + 32 * tb + n]; const float* op_ = ona_l + (g_) * 64 + 32 * mb + 4 * h; \
        _Pragma("unroll") for (int q = 0; q < 4; ++q) gg[q] = *(const f32x4*)(op_ + 8 * q); } while (0)
    GMLP_LOAD_G(g_cur);
    v4u r0, r1; v2u uu[4];
    { const bf16* vp = vptr(u); r0 = *(const v4u*)vp; r1 = *(const v4u*)(vp + 8); const bf16* up = uptr(u);
#pragma unroll
      for (int q = 0; q < 4; ++q) uu[q] = *(const v2u*)(up + 8 * q); }
    for (; u < NU; u += C.G) {
        const int g = u & 7, c = (u >> 3) & 15, b = u >> 7;
        if (g != g_cur) { GMLP_LOAD_G(g); g_cur = g; }
        const size_t R0 = (size_t)b * SEQ + c * 128;
        const int un = (u + C.G < NU) ? u + C.G : u;
        v4u nr0, nr1; v2u nuu[4];
        { float v[16];
#pragma unroll
          for (int e = 0; e < 4; ++e) { v[2 * e] = bflo(r0[e]); v[2 * e + 1] = bfhi(r0[e]); v[8 + 2 * e] = bflo(r1[e]); v[8 + 2 * e + 1] = bfhi(r1[e]); }
          { const bf16* vp = vptr(un); nr0 = *(const v4u*)vp; nr1 = *(const v4u*)(vp + 8); const bf16* up = uptr(un);
#pragma unroll
            for (int q = 0; q < 4; ++q) nuu[q] = *(const v2u*)(up + 8 * q); }
          float s = 0.f;
#pragma unroll
          for (int e = 0; e < 16; ++e) s += v[e];
          s += shx(s, 1); s += shx(s, 2);
          const float mu = s * (1.f / 64.f);
          float q = 0.f;
#pragma unroll
          for (int e = 0; e < 16; ++e) { const float d = v[e] - mu; q += d * d; }
          q += shx(q, 1); q += shx(q, 2);
          const float rstd = rsqrtf(q * (1.f / 64.f) + EPSF);
#pragma unroll
          for (int e = 0; e < 16; ++e) vnT[(16 * qd + e) * 136 + tt] = (unsigned short)f2bf((v[e] - mu) * rstd);
        }
        __syncthreads();
        f32x16 acc;
#pragma unroll
        for (int i = 0; i < 16; ++i) acc[i] = 0.f;
        const LAS unsigned char* ap = C.lds + (32 * mb + n) * 272 + 16 * h;
#pragma unroll
        for (int ks = 0; ks < 8; ++ks) {
            const bf16x8 af = *(const LAS bf16x8*)(ap + 32 * ks);
            acc = __builtin_amdgcn_mfma_f32_32x32x16_bf16(af, wf[ks], acc, 0, 0, 0);
        }
        float y[16]; float ss = 0.f;
#pragma unroll
        for (int q = 0; q < 4; ++q) {
            const float u0 = bflo(uu[q].x), u1 = bfhi(uu[q].x), u2 = bflo(uu[q].y), u3 = bfhi(uu[q].y);
            y[4 * q] = u0 * (acc[4 * q] + bb); y[4 * q + 1] = u1 * (acc[4 * q + 1] + bb); y[4 * q + 2] = u2 * (acc[4 * q + 2] + bb); y[4 * q + 3] = u3 * (acc[4 * q + 3] + bb);
#pragma unroll
            for (int e = 0; e < 4; ++e) ss += y[4 * q + e] * y[4 * q + e]; }
        ss += shx(ss, 32);
        if (h == 0) ssum[mb * 128 + 32 * tb + n] = ss;
        __syncthreads();
        const float tot = ssum[32 * tb + n] + ssum[128 + 32 * tb + n];
        const float rs = rsqrtf(tot * (1.f / 64.f) + EPSF);
        bf16* yp = YMIX + (R0 + 32 * tb + n) * DM + g * 64 + 32 * mb + 4 * h;
#pragma unroll
        for (int q = 0; q < 4; ++q) {
            v2u w; w.x = pk2(y[4 * q] * rs * gg[q].x, y[4 * q + 1] * rs * gg[q].y); w.y = pk2(y[4 * q + 2] * rs * gg[q].z, y[4 * q + 3] * rs * gg[q].w);
            *(v2u*)(yp + 8 * q) = w; }
        r0 = nr0; r1 = nr1;
#pragma unroll
        for (int q = 0; q < 4; ++q) uu[q] = nuu[q];
    }
#undef GMLP_LOAD_G
}

__device__ __forceinline__ void ce_desc(float& a, float& b) { const float hi = fmaxf(a, b), lo = fminf(a, b); a = hi; b = lo; }
template <int K, int J> __device__ __forceinline__ void bstage(float (&v)[16]) {
#pragma unroll
    for (int i = 0; i < 16; ++i) { const int l = i ^ J; if (l > i) { if ((i & K) == 0) ce_desc(v[i], v[l]); else ce_desc(v[l], v[i]); } }
}
__device__ __forceinline__ void bitonic_merge_desc(float (&v)[16]) { bstage<16, 8>(v); bstage<16, 4>(v); bstage<16, 2>(v); bstage<16, 1>(v); }
__device__ __forceinline__ void sort16_desc(float (&v)[16]) {
    ce_desc(v[0], v[1]); ce_desc(v[2], v[3]); ce_desc(v[0], v[2]); ce_desc(v[1], v[3]); ce_desc(v[1], v[2]); ce_desc(v[4], v[5]); ce_desc(v[6], v[7]); ce_desc(v[4], v[6]); ce_desc(v[5], v[7]); ce_desc(v[5], v[6]); ce_desc(v[0], v[4]); ce_desc(v[2], v[6]); ce_desc(v[2], v[4]); ce_desc(v[1], v[5]); ce_desc(v[3], v[7]); ce_desc(v[3], v[5]); ce_desc(v[1], v[2]); ce_desc(v[3], v[4]); ce_desc(v[5], v[6]); ce_desc(v[8], v[9]); ce_desc(v[10], v[11]); ce_desc(v[8], v[10]); ce_desc(v[9], v[11]); ce_desc(v[9], v[10]); ce_desc(v[12], v[13]); ce_desc(v[14], v[15]); ce_desc(v[12], v[14]); ce_desc(v[13], v[15]); ce_desc(v[13], v[14]); ce_desc(v[8], v[12]); ce_desc(v[10], v[14]); ce_desc(v[10], v[12]); ce_desc(v[9], v[13]); ce_desc(v[11], v[15]); ce_desc(v[11], v[13]); ce_desc(v[9], v[10]); ce_desc(v[11], v[12]); ce_desc(v[13], v[14]); ce_desc(v[0], v[8]); ce_desc(v[4], v[12]); ce_desc(v[4], v[8]); ce_desc(v[2], v[10]); ce_desc(v[6], v[14]); ce_desc(v[6], v[10]); ce_desc(v[2], v[4]); ce_desc(v[6], v[8]); ce_desc(v[10], v[12]); ce_desc(v[1], v[9]); ce_desc(v[5], v[13]); ce_desc(v[5], v[9]); ce_desc(v[3], v[11]); ce_desc(v[7], v[15]); ce_desc(v[7], v[11]); ce_desc(v[3], v[5]); ce_desc(v[7], v[9]); ce_desc(v[11], v[13]); ce_desc(v[1], v[2]); ce_desc(v[3], v[4]); ce_desc(v[5], v[6]); ce_desc(v[7], v[8]); ce_desc(v[9], v[10]); ce_desc(v[11], v[12]); ce_desc(v[13], v[14]);
}
__device__ __forceinline__ void merge_top16(float (&L)[16], const float (&N)[16]) {
#pragma unroll
    for (int p = 0; p < 16; ++p) L[p] = fmaxf(L[p], N[15 - p]);
    bitonic_merge_desc(L);
}
__device__ __forceinline__ void insert_desc(float (&L)[16], float v) {
#pragma unroll
    for (int p = 0; p < 16; ++p) { const float hi = fmaxf(L[p], v); v = fminf(L[p], v); L[p] = hi; }
}
__device__ __forceinline__ float embed(float x, unsigned code, unsigned keep_mask) { return __builtin_bit_cast(float, (__builtin_bit_cast(unsigned, x) & keep_mask) | code); }

__device__ __forceinline__ void top16_scores(const bf16* qp  , const LAS unsigned char* kb  , int h, float (&L)[16]) {
    bf16x8 qf[4];
#pragma unroll
    for (int ks = 0; ks < 4; ++ks) qf[ks] = *(const bf16x8*)(qp + 16 * ks);
#pragma unroll
    for (int mbk = 0; mbk < 4; ++mbk) {
        bf16x8 kf[4];
#pragma unroll
        for (int ks = 0; ks < 4; ++ks) kf[ks] = *(const LAS bf16x8*)(kb + mbk * 32 * 144 + 32 * ks);
        f32x16 acc;
#pragma unroll
        for (int i = 0; i < 16; ++i) acc[i] = 0.f;
#pragma unroll
        for (int ks = 0; ks < 4; ++ks) acc = __builtin_amdgcn_mfma_f32_32x32x16_bf16(kf[ks], qf[ks], acc, 0, 0, 0);
        float N[16];
#pragma unroll
        for (int i = 0; i < 16; ++i) N[i] = embed(acc[i], (unsigned)(32 * mbk + (i & 3) + 8 * (i >> 2)) | (unsigned)(4 * h), ~127u);
        sort16_desc(N);
        if (mbk == 0) {
#pragma unroll
            for (int i = 0; i < 16; ++i) L[i] = N[i];
        } else merge_top16(L, N);
    }
    float Pn[16];
#pragma unroll
    for (int i = 0; i < 16; ++i) Pn[i] = shx(L[i], 32);
    merge_top16(L, Pn);
}
__device__ __forceinline__ unsigned lookup7(const unsigned (&p)[4], unsigned a) {
    const unsigned w = a >> 2;
    const unsigned d = (w == 0u) ? p[0] : (w == 1u) ? p[1] : (w == 2u) ? p[2] : p[3];
    return (d >> (8u * (a & 3u))) & 127u;
}
__device__ __forceinline__ void route_item(const bf16* QP, const LAS unsigned char* K1L, const LAS unsigned char* K2L, const float* su_l, const float* sv_l, int* IDX, float* GATE, float* SUA, int tokblk, int hh, int lane) {
    const int n = lane & 31, h = lane >> 5;
    const int tok = tokblk * 32 + n;
    const bf16* qp = QP + (size_t)tok * DM + hh * 128 + 8 * h;
    float L1[16], L2[16];
    top16_scores(qp, K1L + n * 144 + 16 * h, h, L1);
    top16_scores(qp + 64, K2L + n * 144 + 16 * h, h, L2);
    float Cc[16];
#pragma unroll
    for (int bq = 0; bq < 16; ++bq) Cc[bq] = embed(L1[0] + L2[bq], (unsigned)bq, ~255u);
    { float X[16];
#pragma unroll
      for (int i = 0; i < 8; ++i) X[7 - i] = embed(L1[1] + L2[i], 0x10u | (unsigned)i, ~255u);
#pragma unroll
      for (int i = 0; i < 8; ++i) X[8 + i] = embed(L1[8 + i] + L2[0], (unsigned)((8 + i) << 4), ~255u);
      bitonic_merge_desc(X);
      merge_top16(Cc, X); }
    { float Y[16];
      Y[0] = embed(L1[2] + L2[0], 0x20u, ~255u); Y[1] = embed(L1[2] + L2[1], 0x21u, ~255u); Y[2] = embed(L1[2] + L2[2], 0x22u, ~255u);
      Y[3] = embed(L1[2] + L2[3], 0x23u, ~255u); Y[4] = embed(L1[2] + L2[4], 0x24u, ~255u);
      Y[5] = embed(L1[3] + L2[0], 0x30u, ~255u); Y[6] = embed(L1[3] + L2[1], 0x31u, ~255u); Y[7] = embed(L1[3] + L2[2], 0x32u, ~255u); Y[8] = embed(L1[3] + L2[3], 0x33u, ~255u);
      Y[9] = embed(L1[4] + L2[0], 0x40u, ~255u); Y[10] = embed(L1[4] + L2[1], 0x41u, ~255u); Y[11] = embed(L1[4] + L2[2], 0x42u, ~255u);
      Y[12] = embed(L1[5] + L2[0], 0x50u, ~255u); Y[13] = embed(L1[5] + L2[1], 0x51u, ~255u);
      Y[14] = embed(L1[6] + L2[0], 0x60u, ~255u); Y[15] = embed(L1[6] + L2[1], 0x61u, ~255u);
      sort16_desc(Y);
      merge_top16(Cc, Y); }
    insert_desc(Cc, embed(L1[7] + L2[0], 0x70u, ~255u));
    insert_desc(Cc, embed(L1[7] + L2[1], 0x71u, ~255u));
    unsigned p1[4], p2[4];
#pragma unroll
    for (int w = 0; w < 4; ++w) {
        p1[w] = (__builtin_bit_cast(unsigned, L1[4 * w]) & 127u) | ((__builtin_bit_cast(unsigned, L1[4 * w + 1]) & 127u) << 8) | ((__builtin_bit_cast(unsigned, L1[4 * w + 2]) & 127u) << 16) | ((__builtin_bit_cast(unsigned, L1[4 * w + 3]) & 127u) << 24);
        p2[w] = (__builtin_bit_cast(unsigned, L2[4 * w]) & 127u) | ((__builtin_bit_cast(unsigned, L2[4 * w + 1]) & 127u) << 8) | ((__builtin_bit_cast(unsigned, L2[4 * w + 2]) & 127u) << 16) | ((__builtin_bit_cast(unsigned, L2[4 * w + 3]) & 127u) << 24);
    }
    const float m = Cc[0];
    float ex[16]; float sum = 0.f;
#pragma unroll
    for (int p = 0; p < 16; ++p) { ex[p] = exp_fast(Cc[p] - m); sum += ex[p]; }
    const float inv = 1.f / sum;
    const unsigned hmask = h ? 0xffffffffu : 0u;
    int ei[8]; float gv[8];
#pragma unroll
    for (int pp = 0; pp < 8; ++pp) {
        const unsigned cvb = (__builtin_bit_cast(unsigned, Cc[8 + pp]) & hmask) | (__builtin_bit_cast(unsigned, Cc[pp]) & ~hmask);
        const float ev = __builtin_bit_cast(float, (__builtin_bit_cast(unsigned, ex[8 + pp]) & hmask) | (__builtin_bit_cast(unsigned, ex[pp]) & ~hmask));
        const unsigned code = cvb & 255u;
        const unsigned i1 = lookup7(p1, code >> 4), i2 = lookup7(p2, code & 15u);
        ei[pp] = (int)(i1 * 128u + i2); gv[pp] = ev * inv;
    }
    float sq[8];
#pragma unroll
    for (int pp = 0; pp < 8; ++pp) { gv[pp] *= sv_l[ei[pp]]; sq[pp] = su_l[ei[pp]]; }
    int* ip = IDX + (size_t)tok * 128 + hh * 16 + 8 * h;
    float* gp = GATE + (size_t)tok * 128 + hh * 16 + 8 * h;
    float* sp = SUA + (size_t)tok * 128 + hh * 16 + 8 * h;
    *(v4i*)ip = (v4i){ei[0], ei[1], ei[2], ei[3]}; *(v4i*)(ip + 4) = (v4i){ei[4], ei[5], ei[6], ei[7]};
    *(f32x4*)gp = (f32x4){gv[0], gv[1], gv[2], gv[3]}; *(f32x4*)(gp + 4) = (f32x4){gv[4], gv[5], gv[6], gv[7]};
    *(f32x4*)sp = (f32x4){sq[0], sq[1], sq[2], sq[3]}; *(f32x4*)(sp + 4) = (f32x4){sq[4], sq[5], sq[6], sq[7]};
}

__device__ __forceinline__ float reduce16(float (&p)[16], int lane) {
    float r8[8], r4[4], r2[2];
    const bool b3 = (lane & 8) != 0, b2 = (lane & 4) != 0, b1 = (lane & 2) != 0, b0 = (lane & 1) != 0;
#pragma unroll
    for (int i = 0; i < 8; ++i) { const float keep = b3 ? p[i + 8] : p[i], send = b3 ? p[i] : p[i + 8]; r8[i] = keep + shx(send, 8); }
#pragma unroll
    for (int i = 0; i < 4; ++i) { const float keep = b2 ? r8[i + 4] : r8[i], send = b2 ? r8[i] : r8[i + 4]; r4[i] = keep + shx(send, 4); }
#pragma unroll
    for (int i = 0; i < 2; ++i) { const float keep = b1 ? r4[i + 2] : r4[i], send = b1 ? r4[i] : r4[i + 2]; r2[i] = keep + shx(send, 2); }
    float r = (b0 ? r2[1] : r2[0]) + shx(b0 ? r2[0] : r2[1], 1);
    r += shx(r, 16); r += shx(r, 32);
    return r;
}
__device__ __forceinline__ void sort128(unsigned& a0, unsigned& a1, int lane) {
#pragma unroll
    for (int k2 = 2; k2 <= 128; k2 <<= 1) {
#pragma unroll
        for (int j2 = k2 >> 1; j2 > 0; j2 >>= 1) {
            const bool asc = ((2 * lane) & k2) == 0;
            if (j2 == 1) {
                const unsigned lo = a0 < a1 ? a0 : a1, hi = a0 < a1 ? a1 : a0;
                a0 = asc ? lo : hi; a1 = asc ? hi : lo;
            } else {
                const int lm = j2 >> 1;
                const bool takemin = (((lane & lm) == 0) == asc);
                const unsigned o0 = (unsigned)__builtin_amdgcn_ds_bpermute((lane ^ lm) << 2, (int)a0), o1 = (unsigned)__builtin_amdgcn_ds_bpermute((lane ^ lm) << 2, (int)a1);
                const unsigned mn0 = a0 < o0 ? a0 : o0, mx0 = a0 < o0 ? o0 : a0, mn1 = a1 < o1 ? a1 : o1, mx1 = a1 < o1 ? o1 : a1;
                a0 = takemin ? mn0 : mx0; a1 = takemin ? mn1 : mx1;
            }
        }
    }
}
struct ExpertArgs { int commit; const unsigned char* U8; const unsigned char* V8; const float* SUA; const int* IDX; const float* GATE;
                    res_t* XRES; const float* gt2; int last; float* out; const float* final_g; bf16* HB_out; const float* g_next; const float* sh_next; const float* sc_next; const float* gs2; const float* sh2; };
__device__ __forceinline__ void load_h2(const ExpertArgs& A, int tok, int lane, f32x2 (&hv)[8]) {
    const int b = tok >> 11; f32x4 xv[4]; float ss = 0.f;
#pragma unroll
    for (int j = 0; j < 4; ++j) { xv[j] = ld4((const res_t*)(A.XRES + (size_t)tok * DM), lane + 64 * j); ss += (xv[j].x * xv[j].x + xv[j].y * xv[j].y) + (xv[j].z * xv[j].z + xv[j].w * xv[j].w); }
    const float rs = rsqrtf(wave_sum(ss) * (1.f / DM) + EPSF);
#pragma unroll
    for (int j = 0; j < 4; ++j) { const f32x4 gg = ((const f32x4*)(A.gs2 + (size_t)b * DM))[lane + 64 * j], s0 = ((const f32x4*)(A.sh2 + (size_t)b * MODW))[lane + 64 * j];
        const f32x4 o = xv[j] * rs * gg + s0; hv[2 * j] = (f32x2){o.x, o.y}; hv[2 * j + 1] = (f32x2){o.z, o.w}; }
}

__device__ __forceinline__ void token_epilogue(const ExpertArgs& A, int tok, const int (&yi)[16], float cqs, int lane) {
    const int b = tok >> 11;
    f32x4 x2[4]; float ss = 0.f;
#pragma unroll
    for (int j = 0; j < 4; ++j) {
        const f32x4 xv = ld4((const res_t*)(A.XRES + (size_t)tok * DM), lane + 64 * j);
        const f32x4 gg = ((const f32x4*)(A.gt2 + (size_t)b * MODW))[lane + 64 * j];
        const f32x4 yy = {(float)yi[4 * j] * cqs, (float)yi[4 * j + 1] * cqs, (float)yi[4 * j + 2] * cqs, (float)yi[4 * j + 3] * cqs};
        x2[j] = xv + gg * yy;
        ss += (x2[j].x * x2[j].x + x2[j].y * x2[j].y) + (x2[j].z * x2[j].z + x2[j].w * x2[j].w);
    }
    const float rs = rsqrtf(wave_sum(ss) * (1.f / DM) + EPSF);
    if (!A.commit) { asm volatile("" :: "v"(rs)); return; }
    if (A.last) {
#pragma unroll
        for (int j = 0; j < 4; ++j) { const f32x4 gg = ((const f32x4*)A.final_g)[lane + 64 * j]; ((f32x4*)(A.out + (size_t)tok * DM))[lane + 64 * j] = x2[j] * rs * gg; }
    } else {
#pragma unroll
        for (int j = 0; j < 4; ++j) {
            st4(A.XRES + (size_t)tok * DM, lane + 64 * j, x2[j]);
            const f32x4 gg = ((const f32x4*)A.g_next)[lane + 64 * j], s1 = ((const f32x4*)(A.sc_next + (size_t)b * MODW))[lane + 64 * j], s0 = ((const f32x4*)(A.sh_next + (size_t)b * MODW))[lane + 64 * j];
            const f32x4 o = x2[j] * rs * gg * (s1 + 1.f) + s0;
            v2u w; w.x = pk2(o.x, o.y); w.y = pk2(o.z, o.w);
            ((v2u*)(A.HB_out + (size_t)tok * DM))[lane + 64 * j] = w;
        }
    }
}

template <int K> __device__ __forceinline__ int swz_xor(int v) { return __builtin_amdgcn_ds_swizzle(v, ((K & 31) << 10) | 0x1f); }
__device__ __forceinline__ int reduce8_i(const int (&p)[8], int lane, int a32) {
    int r4[4], r2[2];
    const bool b2 = (lane & 4) != 0, b1 = (lane & 2) != 0, b0 = (lane & 1) != 0;
#pragma unroll
    for (int i = 0; i < 4; ++i) { const int keep = b2 ? p[i + 4] : p[i], send = b2 ? p[i] : p[i + 4]; r4[i] = keep + swz_xor<4>(send); }
#pragma unroll
    for (int i = 0; i < 2; ++i) { const int keep = b1 ? r4[i + 2] : r4[i], send = b1 ? r4[i] : r4[i + 2]; r2[i] = keep + swz_xor<2>(send); }
    int r = (b0 ? r2[1] : r2[0]) + swz_xor<1>(b0 ? r2[0] : r2[1]);
    r += swz_xor<8>(r); r += swz_xor<16>(r); r += __builtin_amdgcn_ds_bpermute(a32, r);
    return r;
}
__device__ __forceinline__ int dot4_first(unsigned a, int b) { int d; asm("v_dot4_i32_i8 %0, %1, %2, 0" : "=v"(d) : "v"(a), "v"(b)); return d; }
__device__ __forceinline__ __amdgpu_buffer_rsrc_t make_rsrc(const void* p, unsigned bytes) {
    return __builtin_amdgcn_make_buffer_rsrc((void*)p, (short)0, (int)bytes, 0x00020000); }
template <int SYNTH> __device__ __forceinline__ void expert_rr4(const ExpertArgs& A, int tok0, int tstride, int lane) {
    asm volatile("" : "+v"(lane));
    const unsigned loff = (unsigned)lane << 4; const int a32 = (lane ^ 32) << 2, lg8 = lane >> 3;
    const __amdgpu_buffer_rsrc_t rsrcU = make_rsrc(A.U8, (unsigned)NEXP * 1024u), rsrcV = make_rsrc(A.V8, (unsigned)NEXP * (unsigned)TROWV);
    int S0[4], S1[4], hq[4][4], cpkf[4]; float G0[4], G1[4], Q0[4], Q1[4], c0[4], c1[4], hsc[4], cqs[4], csum[4]; int tk[4];
#pragma unroll
    for (int t = 0; t < 4; ++t) { const int tok = tok0 + t * tstride;
        f32x2 hv[8];
        load_h2(A, tok, lane, hv);
        int idx0 = A.IDX[(size_t)tok * 128 + lane], idx1 = A.IDX[(size_t)tok * 128 + 64 + lane];
        const float gt0 = A.GATE[(size_t)tok * 128 + lane], gt1 = A.GATE[(size_t)tok * 128 + 64 + lane];
        const float su0 = A.SUA[(size_t)tok * 128 + lane], su1 = A.SUA[(size_t)tok * 128 + 64 + lane];
        float mx = 0.f;
#pragma unroll
        for (int i = 0; i < 8; ++i) mx = fmaxf(mx, fmaxf(fabsf(hv[i].x), fabsf(hv[i].y)));
        mx = wave_max(mx);
        const float qs = (mx > 1e-30f) ? 127.f / mx : 0.f; hsc[t] = (mx > 1e-30f) ? mx * (1.f / 127.f) : 0.f;
#pragma unroll
        for (int j = 0; j < 4; ++j) { const int a = (int)rintf(hv[2 * j].x * qs), b = (int)rintf(hv[2 * j].y * qs), c = (int)rintf(hv[2 * j + 1].x * qs), d = (int)rintf(hv[2 * j + 1].y * qs);
            hq[t][j] = (int)(((unsigned)a & 255u) | (((unsigned)b & 255u) << 8) | (((unsigned)c & 255u) << 16) | (((unsigned)d & 255u) << 24)); }
        unsigned k0 = ((unsigned)idx0 << 7) | (unsigned)lane, k1 = ((unsigned)idx1 << 7) | (unsigned)(lane + 64);
        sort128(k0, k1, lane);
        S0[t] = (int)((k0 >> 7) << 10); S1[t] = (int)((k1 >> 7) << 10);
        const int p0 = (int)(k0 & 63u), p1 = (int)(k1 & 63u); const bool h0 = (k0 & 64u) != 0, h1 = (k1 & 64u) != 0;
        const float ga = shf(gt0, p0), gb = shf(gt1, p0), gc = shf(gt0, p1), gd = shf(gt1, p1);
        const float qa = shf(su0, p0), qb = shf(su1, p0), qc = shf(su0, p1), qd = shf(su1, p1);
        G0[t] = h0 ? gb : ga; G1[t] = h1 ? gd : gc; Q0[t] = h0 ? qb : qa; Q1[t] = h1 ? qd : qc;
        c0[t] = 0.f; c1[t] = 0.f; cpkf[t] = 0; cqs[t] = 0.f; csum[t] = 0.f; tk[t] = 0;
    }
    int yi[4][16];
#pragma unroll
    for (int t = 0; t < 4; ++t)
#pragma unroll
        for (int i = 0; i < 16; ++i) yi[t][i] = 0;
#define RR_ISSUE(slot0, t_, g_, tab_) do { const int lb_ = 4 * (g_); _Pragma("unroll") for (int j = 0; j < 8; ++j) { const int e_ = __builtin_amdgcn_readlane((j & 1) ? S1[t_] : S0[t_], lb_ + (j >> 1)); \
        if (SYNTH == 1) { v4u q_; q_[0] = (unsigned)(e_ * 0x01010101) ^ (unsigned)lane; q_[1] = (unsigned)e_ + (unsigned)lane; q_[2] = q_[0] * 3u; q_[3] = q_[1] * 5u; asm volatile("" : "+v"(q_)); ring[(slot0) + j] = q_; } \
        else ring[(slot0) + j] = __builtin_bit_cast(v4u, __builtin_amdgcn_raw_buffer_load_b128(rsrcU, (int)loff, e_, 0)); } __builtin_amdgcn_sched_barrier(0); } while (0)
#define RR_ISSUEV(slot0, t_, g_) do { const int lb_ = 4 * (g_); _Pragma("unroll") for (int j = 0; j < 8; ++j) { const int e_ = __builtin_amdgcn_readlane((j & 1) ? S1[t_] : S0[t_], lb_ + (j >> 1)); \
        if (SYNTH == 1) { v2u q_; q_[0] = (unsigned)(e_ * 0x01010101) ^ (unsigned)lane; q_[1] = (unsigned)e_ + (unsigned)lane; asm volatile("" : "+v"(q_)); ring[(slot0) + j][0] = q_.x; ring[(slot0) + j][1] = q_.y; } \
        else { const v2u w_ = __builtin_bit_cast(v2u, __builtin_amdgcn_raw_buffer_load_b64(rsrcV, (int)(loff >> 1), e_, 0)); ring[(slot0) + j][0] = w_.x; ring[(slot0) + j][1] = w_.y; } } } while (0)
#define RR_U(slot0, t_, g_) do { int p[8]; \
        _Pragma("unroll") for (int j = 7; j >= 0; --j) { int acc = dot4_first(ring[(slot0) + j][0], hq[t_][0]); _Pragma("unroll") for (int w = 1; w < 4; ++w) acc = __builtin_amdgcn_sdot4((int)ring[(slot0) + j][w], hq[t_][w], acc, false); p[j] = acc; }        \
        const int tt_ = reduce8_i(p, lane, a32); tk[t_] = (lg8 == ((g_) & 7)) ? tt_ : tk[t_]; __builtin_amdgcn_sched_barrier(0); } while (0)
#define RR_UW(t_, w_) do { const int src = (lane >> 1) + 32 * (w_); \
        const float gka = shf(G0[t_], src), gkb = shf(G1[t_], src), ska = shf(Q0[t_], src), skb = shf(Q1[t_], src); \
        const float gk = (lane & 1) ? gkb : gka, sk = (lane & 1) ? skb : ska; \
        const float val = pg8::gelu_tanh_f((float)tk[t_] * (sk * hsc[t_])) * gk; \
        const float v0_ = shf(val, 2 * (lane & 31)), v1_ = shf(val, 2 * (lane & 31) + 1); const bool mine = ((lane >> 5) == (w_)); \
        c0[t_] = mine ? v0_ : c0[t_]; c1[t_] = mine ? v1_ : c1[t_]; } while (0)
#define RR_MID(t_) do { const float cm_ = wave_max(fmaxf(fabsf(c0[t_]), fabsf(c1[t_]))); const float q_ = (cm_ > 1e-30f) ? 127.f / cm_ : 0.f; cqs[t_] = (cm_ > 1e-30f) ? cm_ * (1.f / 127.f) : 0.f; \
        const float qa_ = rintf(c0[t_] * q_), qb_ = rintf(c1[t_] * q_); if (V4) csum[t_] = wave_sum(qa_ + qb_); \
        const unsigned pk_ = ((unsigned)(int)qa_ & 255u) | (((unsigned)(int)qb_ & 255u) << 8); \
        const unsigned nb_ = (unsigned)__builtin_amdgcn_ds_bpermute(((lane + 1) & 63) << 2, (int)pk_); cpkf[t_] = (int)(pk_ | (nb_ << 16)); } while (0)
#define RR_V(slot0, t_, g_) do { const int lb_ = 4 * (g_); \
        _Pragma("unroll") for (int gq = 0; gq < 2; ++gq) { const int cpk = __builtin_amdgcn_readlane(cpkf[t_], lb_ + 2 * gq); \
            _Pragma("unroll") for (int c = 0; c < 2; ++c) { \
                const unsigned r0_ = ring[(slot0) + 4 * gq][c], r1_ = ring[(slot0) + 4 * gq + 1][c], r2_ = ring[(slot0) + 4 * gq + 2][c], r3_ = ring[(slot0) + 4 * gq + 3][c]; \
                const unsigned pa_ = __builtin_amdgcn_perm(r1_, r0_, 0x05010400u), pb_ = __builtin_amdgcn_perm(r1_, r0_, 0x07030602u); \
                const unsigned pc_ = __builtin_amdgcn_perm(r3_, r2_, 0x05010400u), pd_ = __builtin_amdgcn_perm(r3_, r2_, 0x07030602u); \
                const unsigned t0_ = __builtin_amdgcn_perm(pc_, pa_, 0x05040100u), t1_ = __builtin_amdgcn_perm(pc_, pa_, 0x07060302u), t2_ = __builtin_amdgcn_perm(pd_, pb_, 0x05040100u), t3_ = __builtin_amdgcn_perm(pd_, pb_, 0x07060302u); \
                yi[t_][4 * c + 0] = __builtin_amdgcn_sdot4((int)t0_, cpk, yi[t_][4 * c + 0], false); yi[t_][8 + 4 * c + 0] = __builtin_amdgcn_sdot4((int)(t0_ & 0x0f0f0f0fu), cpk, yi[t_][8 + 4 * c + 0], false); \
                yi[t_][4 * c + 1] = __builtin_amdgcn_sdot4((int)t1_, cpk, yi[t_][4 * c + 1], false); yi[t_][8 + 4 * c + 1] = __builtin_amdgcn_sdot4((int)(t1_ & 0x0f0f0f0fu), cpk, yi[t_][8 + 4 * c + 1], false); \
                yi[t_][4 * c + 2] = __builtin_amdgcn_sdot4((int)t2_, cpk, yi[t_][4 * c + 2], false); yi[t_][8 + 4 * c + 2] = __builtin_amdgcn_sdot4((int)(t2_ & 0x0f0f0f0fu), cpk, yi[t_][8 + 4 * c + 2], false); \
                yi[t_][4 * c + 3] = __builtin_amdgcn_sdot4((int)t3_, cpk, yi[t_][4 * c + 3], false); yi[t_][8 + 4 * c + 3] = __builtin_amdgcn_sdot4((int)(t3_ & 0x0f0f0f0fu), cpk, yi[t_][8 + 4 * c + 3], false); } \
            __builtin_amdgcn_sched_barrier(0); } } while (0)
    { v4u ring[24];
      RR_ISSUE(0, 0, 0, A.U8); RR_ISSUE(8, 1, 0, A.U8); RR_ISSUE(16, 2, 0, A.U8);
#pragma unroll 1
      for (int it = 0; it < 5; ++it) { const int gb = 3 * it;
          RR_U(0, 0, gb + 0); RR_ISSUE(0, 3, gb + 0, A.U8);
          RR_U(8, 1, gb + 0); RR_ISSUE(8, 0, gb + 1, A.U8);
          RR_U(16, 2, gb + 0); RR_ISSUE(16, 1, gb + 1, A.U8);
          RR_U(0, 3, gb + 0); RR_ISSUE(0, 2, gb + 1, A.U8);
          RR_U(8, 0, gb + 1); if (gb == 6) RR_UW(0, 0); RR_ISSUE(8, 3, gb + 1, A.U8);
          RR_U(16, 1, gb + 1); if (gb == 6) RR_UW(1, 0); RR_ISSUE(16, 0, gb + 2, A.U8);
          RR_U(0, 2, gb + 1); if (gb == 6) RR_UW(2, 0); RR_ISSUE(0, 1, gb + 2, A.U8);
          RR_U(8, 3, gb + 1); if (gb == 6) RR_UW(3, 0); RR_ISSUE(8, 2, gb + 2, A.U8);
          RR_U(16, 0, gb + 2); RR_ISSUE(16, 3, gb + 2, A.U8);
          RR_U(0, 1, gb + 2); RR_ISSUE(0, 0, gb + 3, A.U8);
          RR_U(8, 2, gb + 2); RR_ISSUE(8, 1, gb + 3, A.U8);
          RR_U(16, 3, gb + 2); RR_ISSUE(16, 2, gb + 3, A.U8);
      }
      RR_U(0, 0, 15); RR_ISSUE(0, 3, 15, A.U8); RR_UW(0, 1);
      RR_U(8, 1, 15); RR_ISSUEV(8, 0, 0); RR_UW(1, 1);
      RR_U(16, 2, 15); RR_ISSUEV(16, 1, 0); RR_UW(2, 1);
      RR_U(0, 3, 15); RR_ISSUEV(0, 2, 0); RR_UW(3, 1);
      RR_MID(0); RR_MID(1); RR_MID(2); RR_MID(3);
#pragma unroll 1
      for (int it = 0; it < 5; ++it) { const int gb = 3 * it;
          RR_V(8, 0, gb + 0); RR_ISSUEV(8, 3, gb + 0);
          RR_V(16, 1, gb + 0); RR_ISSUEV(16, 0, gb + 1);
          RR_V(0, 2, gb + 0); RR_ISSUEV(0, 1, gb + 1);
          RR_V(8, 3, gb + 0); RR_ISSUEV(8, 2, gb + 1);
          RR_V(16, 0, gb + 1); RR_ISSUEV(16, 3, gb + 1);
          RR_V(0, 1, gb + 1); RR_ISSUEV(0, 0, gb + 2);
          RR_V(8, 2, gb + 1); RR_ISSUEV(8, 1, gb + 2);
          RR_V(16, 3, gb + 1); RR_ISSUEV(16, 2, gb + 2);
          RR_V(0, 0, gb + 2); RR_ISSUEV(0, 3, gb + 2);
          RR_V(8, 1, gb + 2); RR_ISSUEV(8, 0, gb + 3);
          RR_V(16, 2, gb + 2); RR_ISSUEV(16, 1, gb + 3);
          RR_V(0, 3, gb + 2); RR_ISSUEV(0, 2, gb + 3);
      }
      RR_V(8, 0, 15); RR_ISSUEV(8, 3, 15);
      RR_V(16, 1, 15);
      RR_V(0, 2, 15);
      RR_V(8, 3, 15);
    }
#undef RR_ISSUE
#undef RR_ISSUEV
#undef RR_U
#undef RR_UW
#undef RR_MID
#undef RR_V
    { unsigned pa_ = 0x07060504u, pb_ = 0x03020100u; asm volatile("" : "+v"(pa_), "+v"(pb_));
      if (__builtin_amdgcn_perm(pa_, pb_, 0x06020400u) != 0x06020400u) { cqs[0] = cqs[1] = cqs[2] = cqs[3] = __builtin_nanf(""); } }
#pragma unroll
    for (int t = 0; t < 4; ++t) { const int cs8 = 8 * (int)csum[t]; int yo[16];
#pragma unroll
        for (int c = 0; c < 2; ++c)
#pragma unroll
            for (int i = 0; i < 4; ++i) { const int raw = yi[t][4 * c + i], lo = yi[t][8 + 4 * c + i]; yo[4 * (2 * c) + i] = lo - cs8; yo[4 * (2 * c + 1) + i] = (raw - lo) >> 4; }
        token_epilogue(A, tok0 + t * tstride, yo, cqs[t], lane); }
}


struct Args { const float* in[18]; float* out; unsigned char* ws; int dbg; int pad; };

#define CAS __attribute__((address_space(4)))
__device__ __forceinline__ unsigned long long ld_ptr(int, int i) {
    const volatile CAS unsigned long long* p = (const volatile CAS unsigned long long*)__builtin_amdgcn_kernarg_segment_ptr();
    return p[i];
}
#define INP(i) ((const float*)(const GAS float*)ld_ptr(PT, (i)))
#define WSP() ((unsigned char*)(GAS unsigned char*)ld_ptr(PT, 19))
#define PHASE_CTX() do { int t_ = threadIdx.x; asm volatile("" : "+v"(t_)); C.tid = t_; C.lane = t_ & 63; C.wave = __builtin_amdgcn_readfirstlane(t_ >> 6); \
        int G_ = gridDim.x; asm volatile("" : "+s"(G_)); C.G = G_; const int bx_ = blockIdx.x; C.vcu = (G_ % 8 == 0) ? (bx_ % 8) * (G_ / 8) + bx_ / 8 : bx_; \
        C.gw = C.vcu * NWAVES + C.wave; C.NGW = G_ * NWAVES; C.lds = (LAS unsigned char*)lds_raw; } while (0)
#ifndef PHMASK
#define PHMASK 0xFFFF
#endif
#ifndef REPMASK
#define REPMASK 0
#endif
#define NREP(bit) (((REPMASK) & (bit)) ? 2 : 1)

__global__ void __launch_bounds__(NTHR, 2) mega_fwd(Args args) {
    extern __shared__ __attribute__((aligned(16))) unsigned char lds_raw[];
    Ctx C; C.ws = nullptr;
    PHASE_CTX();
    for (int u = C.tid; u < (LDS_BYTES - LDSCTL_OFF) / 4; u += NTHR) ((LAS unsigned*)(C.lds + LDSCTL_OFF))[u] = 0u;
    __syncthreads();
#define MISC ((volatile LAS unsigned*)((LAS unsigned char*)lds_raw + MISC_OFF))
#define PT 0
    (void)xcd_barrier_post((unsigned*)(WSP() + WS_CTL) + CW_BAR, MISC + 8);
#define GRID_BAR() do { XcdBarrier bar_; bar_.bar = (unsigned*)(WSP() + WS_CTL) + CW_BAR; bar_.x = xb_xcc_id(); bar_.st = MISC + 8; xcd_barrier(bar_); } while (0)


    for (int rep0 = 0; rep0 < NREP(1); ++rep0) {
    if constexpr ((PHMASK & 1) != 0) {
    PHASE_CTX();
    const float* cvec = INP(1); const float* ada_w = INP(2); const float* ada_b = INP(3); float* mod = (float*)(WSP() + WS_MOD);
    for (int it = blockIdx.x; it < 192; it += C.G) {
        const int l = it / 96, e0 = (it % 96) * 64;
        LAS float* cs = (LAS float*)C.lds;
        LAS float* red = (LAS float*)(C.lds + 65536);
        for (int i = C.tid; i < BATCH * DM; i += NTHR) cs[i] = silu_f(cvec[i]);
        __syncthreads();
        float acc[16];
#pragma unroll
        for (int bb = 0; bb < 16; ++bb) acc[bb] = 0.f;
        const float* wp = ada_w + ((size_t)l * DM + C.wave * 128) * MODW + e0 + C.lane;
        const LAS float* cp = cs + C.wave * 128;
#pragma unroll 8
        for (int d = 0; d < 128; ++d) { const float wv = wp[(size_t)d * MODW];
#pragma unroll
            for (int bb = 0; bb < 16; ++bb) acc[bb] += cp[bb * DM + d] * wv; }
#pragma unroll
        for (int bb = 0; bb < 16; ++bb) red[(C.wave * 16 + bb) * 64 + C.lane] = acc[bb];
        __syncthreads();
        for (int o = C.tid; o < 1024; o += NTHR) { const int bb = o >> 6, ln = o & 63; float s = ada_b[l * MODW + e0 + ln];
#pragma unroll
            for (int w8 = 0; w8 < 8; ++w8) s += red[(w8 * 16 + bb) * 64 + ln];
            mod[((size_t)l * BATCH + bb) * MODW + e0 + ln] = s; }
        __syncthreads();
    } }
    if constexpr ((PHMASK & 2) != 0) {
        PHASE_CTX(); unsigned char* ws = WSP();
        const float* w_in = INP(6); const float* w_out = INP(11); const float* peer_wq = INP(12);
        bf16* WIN_T = (bf16*)(ws + WS_WIN); bf16* WOUT_T = (bf16*)(ws + WS_WOUT); bf16* WQ_T = (bf16*)(ws + WS_WQ);
        LAS float* scr = (LAS float*)(C.lds + C.wave * 16384);
        for (int it = C.gw; it < 4608; it += C.NGW) {
            const int l = it / 2304; int r = it % 2304;
            if (r < 1280) { p0_transpose_item(w_in + (size_t)l * DM * PCALL, DM, PCALL, WIN_T + (size_t)l * PCALL * DM, scr, r, C.lane); continue; } r -= 1280;
            if (r < 512) { p0_transpose_item(w_out + (size_t)l * DM * DM, DM, DM, WOUT_T + (size_t)l * DM * DM, scr, r, C.lane); continue; } r -= 512;
            p0_transpose_item(peer_wq + (size_t)l * DM * DM, DM, DM, WQ_T + (size_t)l * DM * DM, scr, r, C.lane);
        }
        const float* sgu_w = INP(7); const float* peer_k1 = INP(13); const float* peer_k2 = INP(14);
        bf16* SGUW = (bf16*)(ws + WS_SGU); bf16* K1B = (bf16*)(ws + WS_K12); bf16* K2B = K1B + 2 * 128 * 64;
        const int gt = C.gw * 64 + C.lane, NGT = C.NGW * 64;
        for (int i = gt; i < 2 * 8 * 128 * 128; i += NGT) { const int s = i & 127, t = (i >> 7) & 127; SGUW[i] = (bf16)f2bf(s <= t ? sgu_w[i] : 0.f); }
        for (int i = gt; i < 2 * 128 * 64; i += NGT) { K1B[i] = (bf16)f2bf(peer_k1[i]); K2B[i] = (bf16)f2bf(peer_k2[i]); }
    }
    if constexpr ((PHMASK & 8) != 0) {
        PHASE_CTX(); unsigned char* ws = WSP(); const float* peer_u = INP(15); const float* peer_v = INP(16);
        float* SCLU = (float*)(ws + WS_SCL); float* SCLV = SCLU + 2 * NEXP; unsigned char* U8 = ws + WS_U8; unsigned char* V8 = ws + WS_V8;
        for (int r = C.gw; r < 4 * NEXP; r += C.NGW) { const int tab = r >> 15, rr = r & 32767;
            if (tab) table_row_i4(peer_v + (size_t)rr * DM, V8 + (size_t)rr * TROWV, SCLV + rr, C.lane);
            else table_row_i8(peer_u + (size_t)rr * DM, U8 + (size_t)rr * TROW, SCLU + rr, C.lane);
        } }
    __syncthreads(); }
    GRID_BAR();
    for (int rep0 = 0; rep0 < NREP(4); ++rep0) {
    if constexpr ((PHMASK & 4) != 0) {
        PHASE_CTX(); unsigned char* ws = WSP(); const float* x = INP(0); const float* norm1_g = INP(4); const float* mod = (const float*)(ws + WS_MOD); bf16* HB = (bf16*)(ws + WS_HB);
        for (int m = 2 * C.gw; m < NT; m += 2 * C.NGW) { const int m2 = m + 1; const int b = m >> 11, b2 = (m2 < NT ? m2 : m) >> 11;
            if (m2 < NT) norm_rows2_bf16(x + (size_t)m * DM, x + (size_t)m2 * DM, norm1_g, mod + (size_t)b * MODW, mod + (size_t)b * MODW + DM, mod + (size_t)b2 * MODW, mod + (size_t)b2 * MODW + DM, HB + (size_t)m * DM, HB + (size_t)m2 * DM, C.lane);
            else norm_row_bf16(x + (size_t)m * DM, norm1_g, mod + (size_t)b * MODW, mod + (size_t)b * MODW + DM, HB + (size_t)m * DM, C.lane); } }
    if constexpr ((PHMASK & 4) != 0) {
        PHASE_CTX(); unsigned char* ws = WSP(); const float* norm2_g = INP(5); const float* mod = (const float*)(ws + WS_MOD);
        const bf16* WQ_T = (const bf16*)(ws + WS_WQ); bf16* WQS = (bf16*)(ws + WS_WQS); float* GS = (float*)(ws + WS_GS); float* CV = (float*)(ws + WS_CVEC);
        for (int it = C.gw; it < 2 * DM; it += C.NGW) { const int l = it >> 10, n = it & 1023;
            f32x4 w[4];
#pragma unroll
            for (int j = 0; j < 4; ++j) w[j] = ld4(WQ_T + ((size_t)l * DM + n) * DM, C.lane + 64 * j) * ((const f32x4*)(norm2_g + l * DM))[C.lane + 64 * j];
#pragma unroll 4
            for (int b = 0; b < BATCH; ++b) { const float* sc = mod + ((size_t)l * BATCH + b) * MODW + 4 * DM; bf16* o = WQS + (((size_t)l * BATCH + b) * DM + n) * DM;
#pragma unroll
                for (int j = 0; j < 4; ++j) st4(o, C.lane + 64 * j, w[j] * (((const f32x4*)sc)[C.lane + 64 * j] + 1.f)); } }
        for (int it = C.gw; it < 2 * BATCH; it += C.NGW) { const int l = it >> 4, b = it & 15; const float* sc = mod + ((size_t)l * BATCH + b) * MODW + 4 * DM;
#pragma unroll
            for (int j = 0; j < 4; ++j) ((f32x4*)(GS + (size_t)it * DM))[C.lane + 64 * j] = ((const f32x4*)(norm2_g + l * DM))[C.lane + 64 * j] * (((const f32x4*)sc)[C.lane + 64 * j] + 1.f); }
        for (int it = C.gw; it < 2 * BATCH * 64; it += C.NGW) { const int l = it >> 10, b = (it >> 6) & 15, n0 = (it & 63) * 16; const float* sh = mod + ((size_t)l * BATCH + b) * MODW + 3 * DM;
            f32x4 s4[4]; float pr[16];
#pragma unroll
            for (int j = 0; j < 4; ++j) s4[j] = ((const f32x4*)sh)[C.lane + 64 * j];
#pragma unroll
            for (int nn = 0; nn < 16; ++nn) { float a = 0.f;
#pragma unroll
                for (int j = 0; j < 4; ++j) { const f32x4 wv = ld4(WQ_T + ((size_t)l * DM + n0 + nn) * DM, C.lane + 64 * j); a += (wv.x * s4[j].x + wv.y * s4[j].y) + (wv.z * s4[j].z + wv.w * s4[j].w); }
                pr[nn] = a; }
            const float r = reduce16(pr, C.lane);
            if (C.lane < 16) CV[((size_t)l * BATCH + b) * DM + n0 + C.lane] = r; } }
    __syncthreads(); }
    GRID_BAR();

#pragma unroll
    for (int l = 0; l < 2; ++l) {
        for (int rep = 0; rep < NREP(16); ++rep) {
        if constexpr ((PHMASK & 16) != 0)
        { PHASE_CTX(); unsigned char* ws = WSP(); bf16* HB = (bf16*)(ws + WS_HB); bf16* WIN_T = (bf16*)(ws + WS_WIN); bf16* PROJ = (bf16*)(ws + WS_PROJ);
          pg8::Gemm g{HB, WIN_T + (size_t)l * PCALL * DM, NT, PCM, DM}; pg8::StaticOrder S; S.init(NT, PCM, C.G, (int)blockIdx.x);
          pg8::EpiProj E{PROJ, PUV, 4, (pg8::bf16_t*)(ws + WS_QI), (pg8::bf16_t*)(ws + WS_KI)};
          pg8::gemm_phase<pg8::EpiProj, pg8::StaticOrder, true, true>(C.lds, g, S, E); }
        if constexpr ((PHMASK & 32) != 0)
        { PHASE_CTX(); unsigned char* ws = WSP(); bf16* HB = (bf16*)(ws + WS_HB); bf16* WIN_T = (bf16*)(ws + WS_WIN); bf16* VT = (bf16*)(ws + WS_VT);
          pg8::Gemm g{WIN_T + (size_t)l * PCALL * DM + (size_t)PCM * DM, HB, 512, NT, DM}; pg8::StaticOrder S; S.init(512, NT, C.G, (int)blockIdx.x);
          pg8::EpiVT E{VT};
          pg8::gemm_phase<pg8::EpiVT, pg8::StaticOrder, true, true>(C.lds, g, S, E); }
        }
        GRID_BAR();
        for (int rep = 0; rep < NREP(64); ++rep) {
        if constexpr ((PHMASK & 64) != 0)
        { PHASE_CTX(); unsigned char* ws = WSP(); const bf16* PROJ = (const bf16*)(ws + WS_PROJ); const bf16* SGUW = (const bf16*)(ws + WS_SGU); bf16* YMIX = (bf16*)(ws + WS_YMIX);
          const float* sgu_b = INP(8); const float* out_norm_a = INP(9);
          gmlp_phase(C, PROJ, SGUW + (size_t)l * 8 * 128 * 128, sgu_b + l * 8 * 128, out_norm_a + l * 512, YMIX);
        }
        __syncthreads(); }
        for (int rep = 0; rep < NREP(128); ++rep) {
        if constexpr ((PHMASK & 128) != 0)
        { PHASE_CTX(); unsigned char* ws = WSP(); const bf16* PROJ = (const bf16*)(ws + WS_PROJ); const bf16* VT = (const bf16*)(ws + WS_VT); bf16* YMIX = (bf16*)(ws + WS_YMIX);
          const float* out_norm_b = INP(10);
          for (int it = C.gw; it < BATCH * 8 * 64; it += C.NGW) { const int qb = 63 - (it & 63), hd = (it >> 6) & 7, b = it >> 9;
            attn_item((const bf16*)(ws + WS_QI), (const bf16*)(ws + WS_KI), VT, YMIX, out_norm_b + l * 512, b, hd, qb, C.lane); } }
        __syncthreads(); }
        GRID_BAR();
        for (int rep = 0; rep < NREP(256); ++rep)
        if constexpr ((PHMASK & 256) != 0)
        { PHASE_CTX(); unsigned char* ws = WSP(); const bf16* YMIX = (const bf16*)(ws + WS_YMIX); const bf16* WOUT_T = (const bf16*)(ws + WS_WOUT); bf16* XRES = (bf16*)(ws + WS_XRES);
          const float* modl = (const float*)(ws + WS_MOD) + (size_t)l * BATCH * MODW; const float* x = INP(0);
          pg8::Gemm g{YMIX, WOUT_T + (size_t)l * DM * DM, NT, DM, DM}; pg8::StaticOrder S; S.init(NT, DM, C.G, (int)blockIdx.x);
          pg8::EpiResid E{l == 0 ? x : (const float*)nullptr, (const pg8::bf16_t*)XRES, (rep + 1 < NREP(256)) ? (pg8::bf16_t*)(GAS float*)ld_ptr(PT, 18) : (pg8::bf16_t*)XRES, modl + 2 * DM, FOLD ? (float*)(ws + WS_SS) : (float*)nullptr};
          pg8::gemm_phase<pg8::EpiResid, pg8::StaticOrder, true, true>(C.lds, g, S, E); }
        GRID_BAR();
        for (int rep = 0; rep < NREP(1024); ++rep)
        if constexpr ((PHMASK & 1024) != 0)
        { PHASE_CTX(); unsigned char* ws = WSP(); const bf16* XRES = (const bf16*)(ws + WS_XRES); const bf16* WQS = (const bf16*)(ws + WS_WQS); bf16* QP = (bf16*)(ws + WS_PROJ);
          pg8::Gemm g{XRES, WQS + (size_t)l * BATCH * DM * DM, NT, DM, DM}; pg8::BatchOrder S; S.init(NT, DM, C.G, (int)blockIdx.x); S.bs = (size_t)DM * DM * 2;
          pg8::EpiQ E{QP, (const float*)(ws + WS_SS), (const float*)(ws + WS_CVEC) + (size_t)l * BATCH * DM};
          pg8::gemm_phase<pg8::EpiQ, pg8::BatchOrder, true, true>(C.lds, g, S, E); }
        GRID_BAR();
        for (int rep = 0; rep < NREP(4096); ++rep)
        if constexpr ((PHMASK & 4096) != 0)
        { PHASE_CTX(); unsigned char* ws = WSP(); ExpertArgs A; A.commit = (rep + 1 == NREP(4096));
          const float* mod = (const float*)(ws + WS_MOD);
          A.U8 = ws + WS_U8 + (size_t)l * NEXP * TROW; A.V8 = ws + WS_V8 + (size_t)l * NEXP * TROWV; A.SUA = (const float*)(ws + WS_YMIX + 32 * MiB);
          A.IDX = (const int*)(ws + WS_YMIX); A.GATE = (const float*)(ws + WS_YMIX + 16 * MiB); A.XRES = (res_t*)(ws + WS_XRES);
          A.gt2 = mod + (size_t)l * BATCH * MODW + 5 * DM; A.last = (l == 1); A.out = (float*)(GAS float*)ld_ptr(PT, 18); A.final_g = INP(17);
          A.gs2 = (const float*)(ws + WS_GS) + (size_t)l * BATCH * DM; A.sh2 = mod + (size_t)l * BATCH * MODW + 3 * DM;
          A.HB_out = (bf16*)(ws + WS_HB); A.g_next = INP(4) + DM; A.sh_next = mod + (size_t)BATCH * MODW; A.sc_next = mod + (size_t)BATCH * MODW + DM;
              {
                { const bf16* K1B = (const bf16*)(ws + WS_K12); const bf16* K2B = K1B + 2 * 128 * 64; const bf16* k1 = K1B + l * 128 * 64; const bf16* k2 = K2B + l * 128 * 64;
                  __syncthreads();
                  for (int i = C.tid; i < 2 * 128 * 8; i += NTHR) { const int tb = i >> 10, r = (i >> 3) & 127, c = i & 7;
                      *(LAS v4u*)(C.lds + tb * 18432 + r * 144 + c * 16) = *(const v4u*)((tb ? k2 : k1) + r * 64 + c * 8); }
                  __syncthreads(); }
                for (int blk = C.vcu; blk < NT / 32; blk += C.G) {
                    { unsigned char* wr_ = WSP();
                      route_item((const bf16*)(wr_ + WS_PROJ), C.lds, C.lds + 18432, (const float*)(wr_ + WS_SCL) + l * NEXP, (const float*)(wr_ + WS_SCL) + 2 * NEXP + l * NEXP,
                                 (int*)(wr_ + WS_YMIX), (float*)(wr_ + WS_YMIX + 16 * MiB), (float*)(wr_ + WS_YMIX + 32 * MiB), blk, C.wave, lane_now()); }
                    __syncthreads();
                    asm volatile("buffer_inv sc0" ::: "memory");
                    expert_rr4<0>(A, 32 * blk + 4 * C.wave, 1, lane_now()); } } }
        if (l == 0) GRID_BAR();
    }
}
}

extern "C" void kernel_launch(void* const* d_in, const int* in_sizes, int n_in, void* d_out, int out_size, void* d_ws, size_t ws_size, hipStream_t stream) {
    using namespace mk;
    static int grid = 0;
    if (grid == 0) {
        if (n_in != 18 || ws_size < WS_END) { fprintf(stderr, "kernel_launch: unexpected n_in %d or ws_size %zu (< %zu)\n", n_in, ws_size, (size_t)WS_END); grid = -1; return; }
        int dev = 0, cus = 0, per_cu = 0;
        if (hipGetDevice(&dev) != hipSuccess || hipDeviceGetAttribute(&cus, hipDeviceAttributeMultiprocessorCount, dev) != hipSuccess) { grid = -1; return; }
        if (hipFuncSetAttribute((const void*)mega_fwd, hipFuncAttributeMaxDynamicSharedMemorySize, LDS_BYTES) != hipSuccess) { fprintf(stderr, "kernel_launch: hipFuncSetAttribute failed\n"); grid = -1; return; }
        if (hipOccupancyMaxActiveBlocksPerMultiprocessor(&per_cu, (const void*)mega_fwd, NTHR, LDS_BYTES) != hipSuccess || per_cu < 1)
            fprintf(stderr, "kernel_launch: occupancy query reports %d workgroups per CU\n", per_cu);
        (void)hipGetLastError();
        grid = cus;
    }
    if (grid < 0) return;
    (void)hipMemsetAsync((char*)d_ws + WS_CTL, 0, CTL_ZERO_BYTES, stream);
    Args a{};
    for (int i = 0; i < 18; ++i) a.in[i] = (const float*)d_in[i];
    a.out = (float*)d_out; a.ws = (unsigned char*)d_ws; a.dbg = 0; a.pad = 0;
    hipLaunchKernelGGL(mega_fwd, dim3(grid), dim3(NTHR), LDS_BYTES, stream, a);
}
```

```cpp
#include <hip/hip_runtime.h>
#include <cstdio>
#include <cstdint>
namespace pg8 {
#define PG8_LAS __attribute__((address_space(3)))
typedef unsigned short bf16_t;
typedef short bf16x8 __attribute__((ext_vector_type(8)));
typedef float f32x4 __attribute__((ext_vector_type(4)));
typedef unsigned u32x4 __attribute__((ext_vector_type(4)));
constexpr int BM = 256, BK = 64, HALF = 128, HTB = HALF * BK * 2  , STAGE_BYTES = 8 * HTB, NXCD = 8, WGM = 8;

__host__ __device__ __forceinline__ int lds_byte(int r, int c) { const int st = (r >> 4) * 2 + (c >> 5), rr = r & 15, cc = c & 31, ob = rr * 64 + cc * 2; return st * 1024 + (ob ^ (((ob >> 9) & 1) << 5)); }
__host__ __device__ __forceinline__ void stage_rc(int b, int& R, int& C) { const int st = b / 1024, sb = b % 1024, swz = sb ^ (((sb >> 9) & 1) << 5); R = (st >> 1) * 16 + swz / 64; C = (st & 1) * 32 + (swz % 64) / 2; }
__host__ __device__ __forceinline__ int perm32(int rho) { const int n = rho >> 4, i = rho & 15; return 8 * (i >> 2) + 4 * n + (i & 3); }

struct Unit { int pm, pn; };
struct Gemm { const bf16_t* A; const bf16_t* Bt; int M, N, K; };

struct StaticOrder {
    int nM, nN, nwg, G, c;
    __host__ __device__ void init(int M, int N, int G_, int c_) { nM = M / BM; nN = N / BM; nwg = nM * nN; G = G_; c = c_; }
    __host__ __device__ bool next(int i, Unit& u) const {
        const long L = (long)i * G + c; if (L >= nwg) return false;
        int wgid = (int)L; { const int q = nwg / NXCD, r = nwg % NXCD, xcd = wgid % NXCD, off = wgid / NXCD; wgid = (xcd < r ? xcd * (q + 1) : r * (q + 1) + (xcd - r) * q) + off; }
        const int nig = WGM * nN, gid = wgid / nig, fm = gid * WGM, gsz = (nM - fm) < WGM ? (nM - fm) : WGM;
        u.pm = fm + ((wgid % nig) % gsz); u.pn = (wgid % nig) / gsz; return true;
    }
    __device__ __forceinline__ void a_ready(const Unit&) const {}
    __device__ __forceinline__ void done(const Unit&) const {}
    __device__ __forceinline__ size_t b_shift(const Unit&) const { return 0; }
};
struct BatchOrder : StaticOrder {
    size_t bs;
    __device__ __forceinline__ size_t b_shift(const Unit& u) const { return (size_t)(u.pm >> 3) * bs; }
};

__device__ __forceinline__ unsigned cvt_pk_bf16(float lo, float hi) { unsigned r; asm volatile("v_cvt_pk_bf16_f32 %0, %1, %2" : "=v"(r) : "v"(lo), "v"(hi)); return r; }
typedef float f32x2 __attribute__((ext_vector_type(2)));
__device__ __forceinline__ f32x2 gelu_pk(f32x2 v) {
    const f32x2 av = __builtin_elementwise_abs(v), d = av * 0.2316418882f + 1.0f;
    f32x2 t; t.x = __builtin_amdgcn_rcpf(d.x); t.y = __builtin_amdgcn_rcpf(d.y);
    f32x2 q = t * 0.5307027145f + (-0.7265760135f); q = q * t + 0.7107068705f; q = q * t + (-0.142248368f); q = q * t + 0.127414796f; q = q * t;
    const f32x2 s = (v * v) * (-0.72134752044f);
    f32x2 e; e.x = __builtin_amdgcn_exp2f(s.x); e.y = __builtin_amdgcn_exp2f(s.y);
    const f32x2 m = v * (q * e), r = v - m;
    f32x2 o; o.x = v.x < 0.f ? m.x : r.x; o.y = v.y < 0.f ? m.y : r.y; return o;
}

template <int ACT  > struct EpiBf16 {
    static constexpr bool PERM = true, AFTER_DRAIN = false; static_assert(ACT == 0 || ACT == 1, "EpiBf16: ACT is 0 (none) or 1 (gelu_pk)");
    bf16_t* O; int ldc; const float* bias; int split_cols; size_t split_stride; float scale0;
    __device__ __forceinline__ void operator()(const f32x4 (&acc)[2][2][4][2], const Unit& u, int wr, int wc, int fr, int fq) const {
        const int row0 = u.pm * BM + wr * 64 + fr; int colt = u.pn * BM; bf16_t* base = O;
        float sc = 1.f; if (split_cols) { const int t = colt / split_cols; base += (size_t)t * split_stride; colt -= t * split_cols; if (t == 0) sc = scale0; }
        const int col0 = colt + wc * 32 + 8 * fq, bcol0 = u.pn * BM + wc * 32 + 8 * fq;
        f32x4 bv[2][2];
#pragma unroll
        for (int bj = 0; bj < 2; ++bj)
#pragma unroll
            for (int n = 0; n < 2; ++n) bv[bj][n] = bias ? *(const f32x4*)(bias + bcol0 + bj * HALF + 4 * n) : (f32x4){0.f, 0.f, 0.f, 0.f};
#pragma unroll
        for (int ai = 0; ai < 2; ++ai)
#pragma unroll
            for (int m = 0; m < 4; ++m) { bf16_t* rowp = base + (size_t)(row0 + ai * HALF + m * 16) * ldc + col0;
#pragma unroll
                for (int bj = 0; bj < 2; ++bj) { f32x4 v0 = acc[ai][bj][m][0] + bv[bj][0], v1 = acc[ai][bj][m][1] + bv[bj][1];
                    if (ACT == 1) { f32x2 a = gelu_pk((f32x2){v0[0], v0[1]}), b = gelu_pk((f32x2){v0[2], v0[3]}), c = gelu_pk((f32x2){v1[0], v1[1]}), d = gelu_pk((f32x2){v1[2], v1[3]});
                        v0 = (f32x4){a.x, a.y, b.x, b.y}; v1 = (f32x4){c.x, c.y, d.x, d.y}; }
                    v0 = v0 * sc; v1 = v1 * sc; u32x4 w; w.x = cvt_pk_bf16(v0[0], v0[1]); w.y = cvt_pk_bf16(v0[2], v0[3]); w.z = cvt_pk_bf16(v1[0], v1[1]); w.w = cvt_pk_bf16(v1[2], v1[3]);
                    *(u32x4*)(rowp + bj * HALF) = w; } }
    }
};

template <class Epi, class Sched, bool ALIGN_EPI = false, bool SP2 = false>
__device__ __forceinline__ void gemm_phase(PG8_LAS unsigned char* lds, const Gemm g, const Sched& S, const Epi& E) {
    int tid_ = threadIdx.x; asm volatile("" : "+v"(tid_));
    const int tid = tid_, wid = __builtin_amdgcn_readfirstlane(tid >> 6), lane = tid & 63, wr = wid >> 2, wc = wid & 3, fr = lane & 15, fq = lane >> 4;
    const int K = g.K, nt = K / BK;
    unsigned voffA[2], voffB[2];
#pragma unroll
    for (int i = 0; i < 2; ++i) { int R, C; stage_rc(tid * 16 + i * 8192, R, C); const int Rb = Epi::PERM ? ((R & ~31) + perm32(R & 31)) : R;
        voffA[i] = (unsigned)(R * K + C) * 2u; voffB[i] = (unsigned)(Rb * K + C) * 2u; }
    const size_t kstep = (size_t)(BK * 2);
    const size_t hstep = (size_t)HALF * K * 2;
    const size_t tstep = 2 * hstep;
    const unsigned ldsw = (unsigned)wid * 1024u;
    const int aoff = lds_byte(wr * 64 + fr, fq * 8), boff = lds_byte(wc * 32 + fr, fq * 8);
#define PG8_SA(b, h) (((b) * 2 + (h)) * HTB)
#define PG8_SB(b, h) ((4 + (b) * 2 + (h)) * HTB)
#define PG8_STAGE(bufoff, gbase, voff) do { _Pragma("unroll") for (int _i = 0; _i < 2; ++_i) \
        __builtin_amdgcn_global_load_lds((const unsigned*)((const char*)(gbase) + (voff)[_i]), (PG8_LAS unsigned*)(lds + (bufoff) + ldsw + _i * 8192), 16, 0, 0); } while (0)
#define PG8_LDA(dst, b, h) do { _Pragma("unroll") for (int m = 0; m < 4; ++m) _Pragma("unroll") for (int k = 0; k < 2; ++k) dst[m][k] = *(const PG8_LAS bf16x8*)(lds + PG8_SA(b, h) + aoff + m * 2048 + k * 1024); } while (0)
#define PG8_LDB(dst, b, h) do { _Pragma("unroll") for (int n = 0; n < 2; ++n) _Pragma("unroll") for (int k = 0; k < 2; ++k) dst[n][k] = *(const PG8_LAS bf16x8*)(lds + PG8_SB(b, h) + boff + n * 2048 + k * 1024); } while (0)
#define PG8_MMA(ai, bj, At, Bt) do { __builtin_amdgcn_s_setprio(1); _Pragma("unroll") for (int m = 0; m < 4; ++m) _Pragma("unroll") for (int n = 0; n < 2; ++n) _Pragma("unroll") for (int k = 0; k < 2; ++k) \
        acc[ai][bj][m][n] = __builtin_amdgcn_mfma_f32_16x16x32_bf16(Bt[n][k], At[m][k], acc[ai][bj][m][n], 0, 0, 0); __builtin_amdgcn_s_setprio(0); } while (0)
#define PG8_WAIT_V(n) asm volatile("s_waitcnt vmcnt(" #n ")" ::: "memory")
#define PG8_WAIT_L(n) asm volatile("s_waitcnt lgkmcnt(" #n ")" ::: "memory")
#define PG8_BAR __builtin_amdgcn_s_barrier()
#define PG8_SCHED __builtin_amdgcn_sched_barrier(0)
    Unit cur, nxt; int ui = 0;
    if (!S.next(0, cur)) return;
    f32x4 acc[2][2][4][2];
#pragma unroll
    for (int a = 0; a < 2; ++a)
#pragma unroll
        for (int b = 0; b < 2; ++b)
#pragma unroll
            for (int m = 0; m < 4; ++m)
#pragma unroll
                for (int n = 0; n < 2; ++n) acc[a][b][m][n] = (f32x4){0.f, 0.f, 0.f, 0.f};
    bf16x8 At[4][2], B0[2][2], B1[2][2];
    const char* cA = (const char*)g.A + (size_t)cur.pm * tstep; const char* cB = (const char*)g.Bt + (size_t)cur.pn * tstep + S.b_shift(cur);
    S.a_ready(cur);
    if constexpr (SP2) {
        PG8_STAGE(PG8_SB(0, 0), cB, voffB); PG8_STAGE(PG8_SB(0, 1), cB + hstep, voffB); PG8_STAGE(PG8_SA(0, 0), cA, voffA); PG8_STAGE(PG8_SA(0, 1), cA + hstep, voffA);
        if (wr == 1) PG8_BAR;
        PG8_WAIT_V(2); PG8_BAR;
        PG8_STAGE(PG8_SB(1, 0), cB + kstep, voffB); PG8_STAGE(PG8_SA(1, 0), cA + kstep, voffA); PG8_STAGE(PG8_SB(1, 1), cB + hstep + kstep, voffB);
        PG8_WAIT_V(6); PG8_BAR;
    } else {
        PG8_STAGE(PG8_SB(0, 0), cB, voffB); PG8_STAGE(PG8_SA(0, 0), cA, voffA); PG8_STAGE(PG8_SB(0, 1), cB + hstep, voffB); PG8_STAGE(PG8_SA(0, 1), cA + hstep, voffA);
        if (wr == 1) PG8_BAR;
        PG8_WAIT_V(4); PG8_BAR;
        PG8_STAGE(PG8_SB(1, 0), cB + kstep, voffB); PG8_STAGE(PG8_SA(1, 0), cA + kstep, voffA); PG8_STAGE(PG8_SB(1, 1), cB + hstep + kstep, voffB);
        PG8_WAIT_V(6); PG8_BAR;
    }
    for (;;) {
        const bool has_next = S.next(ui + 1, nxt);
        const char* nA = has_next ? (const char*)g.A + (size_t)nxt.pm * tstep : cA; const char* nB = has_next ? (const char*)g.Bt + (size_t)nxt.pn * tstep + S.b_shift(nxt) : cB;
        for (int t = 0; t < nt; t += 2) {
            const bool last = (t == nt - 2);
            const char* a1 = cA + (size_t)(t + 1) * kstep;
            const char* a2 = last ? nA : cA + (size_t)(t + 2) * kstep; const char* b2 = last ? nB : cB + (size_t)(t + 2) * kstep;
            const char* a3 = a2 + kstep; const char* b3 = b2 + kstep;
            if (last && has_next) S.a_ready(nxt);
            if constexpr (SP2) {
            PG8_LDB(B0, 0, 0); PG8_LDB(B1, 0, 1); PG8_SCHED; PG8_LDA(At, 0, 0); PG8_STAGE(PG8_SA(1, 1), a1 + hstep, voffA);
            PG8_WAIT_V(8); PG8_WAIT_L(0); PG8_BAR; PG8_MMA(0, 0, At, B0); PG8_MMA(0, 1, At, B1); PG8_BAR; PG8_SCHED;
            PG8_LDA(At, 0, 1); PG8_STAGE(PG8_SB(0, 0), b2, voffB); PG8_STAGE(PG8_SB(0, 1), b2 + hstep, voffB); PG8_STAGE(PG8_SA(0, 0), a2, voffA);
            PG8_WAIT_V(8); PG8_WAIT_L(0); PG8_BAR; PG8_MMA(1, 0, At, B0); PG8_MMA(1, 1, At, B1); PG8_BAR; PG8_SCHED;
            PG8_LDB(B0, 1, 0); PG8_LDB(B1, 1, 1); PG8_SCHED; PG8_LDA(At, 1, 0); PG8_STAGE(PG8_SA(0, 1), a2 + hstep, voffA);
            PG8_WAIT_V(8); PG8_WAIT_L(0); PG8_BAR; PG8_MMA(0, 0, At, B0); PG8_MMA(0, 1, At, B1); PG8_BAR; PG8_SCHED;
            PG8_LDA(At, 1, 1); PG8_STAGE(PG8_SB(1, 0), b3, voffB); PG8_STAGE(PG8_SB(1, 1), b3 + hstep, voffB); PG8_STAGE(PG8_SA(1, 0), a3, voffA);
            PG8_WAIT_V(8); PG8_WAIT_L(0); PG8_BAR; PG8_MMA(1, 0, At, B0); PG8_MMA(1, 1, At, B1); PG8_BAR; PG8_SCHED;
            } else {
            PG8_LDB(B0, 0, 0); PG8_SCHED; PG8_LDA(At, 0, 0); PG8_STAGE(PG8_SA(1, 1), a1 + hstep, voffA);
            PG8_WAIT_L(8); PG8_BAR; PG8_WAIT_L(0); PG8_MMA(0, 0, At, B0); PG8_BAR; PG8_SCHED;
            PG8_LDB(B1, 0, 1); PG8_STAGE(PG8_SB(0, 0), b2, voffB);
            PG8_BAR; PG8_WAIT_L(0); PG8_MMA(0, 1, At, B1); PG8_BAR;
            PG8_LDA(At, 0, 1); PG8_STAGE(PG8_SA(0, 0), a2, voffA);
            PG8_BAR; PG8_WAIT_L(0); PG8_MMA(1, 0, At, B0); PG8_BAR; PG8_SCHED;
            PG8_STAGE(PG8_SB(0, 1), b2 + hstep, voffB);
            PG8_WAIT_V(6); PG8_BAR; PG8_MMA(1, 1, At, B1); PG8_BAR;
            PG8_LDB(B0, 1, 0); PG8_SCHED; PG8_LDA(At, 1, 0); PG8_STAGE(PG8_SA(0, 1), a2 + hstep, voffA);
            PG8_WAIT_L(8); PG8_BAR; PG8_WAIT_L(0); PG8_MMA(0, 0, At, B0); PG8_BAR; PG8_SCHED;
            PG8_LDB(B1, 1, 1); PG8_STAGE(PG8_SB(1, 0), b3, voffB);
            PG8_BAR; PG8_WAIT_L(0); PG8_MMA(0, 1, At, B1); PG8_BAR;
            PG8_LDA(At, 1, 1); PG8_STAGE(PG8_SA(1, 0), a3, voffA);
            PG8_BAR; PG8_WAIT_L(0); PG8_MMA(1, 0, At, B0); PG8_BAR; PG8_SCHED;
            PG8_STAGE(PG8_SB(1, 1), b3 + hstep, voffB);
            PG8_WAIT_V(6); PG8_BAR; PG8_MMA(1, 1, At, B1); PG8_BAR;
            }
        }
        if constexpr (ALIGN_EPI) { if (wr == 0) PG8_BAR; }
        if constexpr (!Epi::AFTER_DRAIN) { E(acc, cur, wr, wc, fr, fq); S.done(cur); }
        if (!has_next) break;
#pragma unroll
        for (int a = 0; a < 2; ++a)
#pragma unroll
            for (int b = 0; b < 2; ++b)
#pragma unroll
                for (int m = 0; m < 4; ++m)
#pragma unroll
                    for (int n = 0; n < 2; ++n) acc[a][b][m][n] = (f32x4){0.f, 0.f, 0.f, 0.f};
        cur = nxt; cA = nA; cB = nB; ++ui;
        if constexpr (ALIGN_EPI) { if (wr == 1) PG8_BAR; }
    }
    PG8_WAIT_V(0);
    if constexpr (!ALIGN_EPI) { if (wr == 0) PG8_BAR; }
    PG8_BAR;
    if constexpr (Epi::AFTER_DRAIN) { E.fused(acc, cur, wr, wc, fr, fq, lds, wid, lane); S.done(cur); }
#undef PG8_SA
#undef PG8_SB
#undef PG8_STAGE
#undef PG8_LDA
#undef PG8_LDB
#undef PG8_MMA
#undef PG8_WAIT_V
#undef PG8_WAIT_L
#undef PG8_BAR
#undef PG8_SCHED
}
}

#ifndef FOLD
#define FOLD 1
#endif
#ifndef RMERGE
#define RMERGE 1
#endif
#ifndef V4
#define V4 1
#endif
namespace pg8 {
__device__ __forceinline__ float lane_xchg(float v, int src_lane) { return __builtin_bit_cast(float, __builtin_amdgcn_ds_bpermute(src_lane << 2, __builtin_bit_cast(int, v))); }
__device__ __forceinline__ float gelu_tanh_f(float x) {
    const float u2 = 1.5957691216057308f * x * (1.f + 0.044715f * x * x);
    const float e = __builtin_amdgcn_exp2f(-u2 * 1.4426950408889634f);
    return x * __builtin_amdgcn_rcpf(1.f + e);
}
struct EpiProj {
    static constexpr bool PERM = true, AFTER_DRAIN = false;
    bf16_t* O; int ldc; int gelu_tiles; bf16_t* QI; bf16_t* KI;
    __device__ __forceinline__ void operator()(const f32x4 (&acc)[2][2][4][2], const Unit& u, int wr, int wc, int fr, int fq) const {
        const int row0 = u.pm * BM + wr * 64 + fr, col0 = u.pn * BM + wc * 32 + 8 * fq;
        const bool act = u.pn < gelu_tiles;
#pragma unroll
        for (int ai = 0; ai < 2; ++ai)
#pragma unroll
            for (int m = 0; m < 4; ++m) { const int row = row0 + ai * HALF + m * 16; bf16_t* rowp = O + (size_t)row * ldc + col0;
#pragma unroll
                for (int bj = 0; bj < 2; ++bj) { f32x4 v0 = acc[ai][bj][m][0], v1 = acc[ai][bj][m][1];
                    if (act) {
#pragma unroll
                        for (int e = 0; e < 4; ++e) { v0[e] = gelu_tanh_f(v0[e]); v1[e] = gelu_tanh_f(v1[e]); } }
                    u32x4 w; w.x = cvt_pk_bf16(v0[0], v0[1]); w.y = cvt_pk_bf16(v0[2], v0[3]); w.z = cvt_pk_bf16(v1[0], v1[1]); w.w = cvt_pk_bf16(v1[2], v1[3]);
                    if (u.pn < 4) *(u32x4*)(rowp + bj * HALF) = w;
                    else { const int c = col0 + bj * HALF - 1024; const int isk = c >> 9, hd = (c >> 6) & 7, dch = (c >> 3) & 7; const int pos = row & 31;
                        const int p2 = isk ? ((pos & ~12) | ((pos & 4) << 1) | ((pos & 8) >> 1)) : pos;
                        const size_t cell = ((((size_t)(row >> 5) * 8 + hd) * 4 + (dch >> 1)) * 2 + (dch & 1)) * 32 + p2;
                        *(u32x4*)((isk ? KI : QI) + cell * 8) = w; } } }
    }
};
struct EpiResid {
    static constexpr bool PERM = true, AFTER_DRAIN = false;
    const float* xin_f; const bf16_t* xin_h; bf16_t* xout; const float* gt; float* SS;
    __device__ __forceinline__ void operator()(const f32x4 (&acc)[2][2][4][2], const Unit& u, int wr, int wc, int fr, int fq) const {
        const int row0 = u.pm * BM + wr * 64 + fr, col0 = u.pn * BM + wc * 32 + 8 * fq;
        const int b = (u.pm * BM) >> 11;
        f32x4 g[2][2];
        float psq[2][4];
#pragma unroll
        for (int ai = 0; ai < 2; ++ai)
#pragma unroll
            for (int m = 0; m < 4; ++m) psq[ai][m] = 0.f;
#pragma unroll
        for (int bj = 0; bj < 2; ++bj)
#pragma unroll
            for (int n = 0; n < 2; ++n) g[bj][n] = *(const f32x4*)(gt + (size_t)b * 6144 + col0 + bj * HALF + 4 * n);
#pragma unroll
        for (int ai = 0; ai < 2; ++ai)
#pragma unroll
            for (int m = 0; m < 4; ++m) { const size_t ro = (size_t)(row0 + ai * HALF + m * 16) * 1024 + col0;
#pragma unroll
                for (int bj = 0; bj < 2; ++bj) { const size_t o = ro + bj * HALF; f32x4 x0, x1;
                    if (xin_f) { x0 = *(const f32x4*)(xin_f + o); x1 = *(const f32x4*)(xin_f + o + 4); }
                    else { const u32x4 w = *(const u32x4*)(xin_h + o);
                        x0 = (f32x4){__builtin_bit_cast(float, w.x << 16), __builtin_bit_cast(float, w.x & 0xffff0000u), __builtin_bit_cast(float, w.y << 16), __builtin_bit_cast(float, w.y & 0xffff0000u)};
                        x1 = (f32x4){__builtin_bit_cast(float, w.z << 16), __builtin_bit_cast(float, w.z & 0xffff0000u), __builtin_bit_cast(float, w.w << 16), __builtin_bit_cast(float, w.w & 0xffff0000u)}; }
                    const f32x4 v0 = x0 + g[bj][0] * acc[ai][bj][m][0], v1 = x1 + g[bj][1] * acc[ai][bj][m][1];
                    { const f32x4 q0 = v0 * v0, q1 = v1 * v1; psq[ai][m] += ((q0[0] + q0[1]) + (q0[2] + q0[3])) + ((q1[0] + q1[1]) + (q1[2] + q1[3])); }
                    u32x4 w; w.x = cvt_pk_bf16(v0[0], v0[1]); w.y = cvt_pk_bf16(v0[2], v0[3]); w.z = cvt_pk_bf16(v1[0], v1[1]); w.w = cvt_pk_bf16(v1[2], v1[3]);
                    *(u32x4*)(xout + o) = w; } }
        if (SS) { const int ln = fr + 16 * fq;
#pragma unroll
            for (int ai = 0; ai < 2; ++ai)
#pragma unroll
                for (int m = 0; m < 4; ++m) { float sq = psq[ai][m]; sq += lane_xchg(sq, ln ^ 16); sq += lane_xchg(sq, ln ^ 32);
                    if (fq == 0) SS[(size_t)(row0 + ai * HALF + m * 16) * 16 + u.pn * 4 + wc] = sq; } }
    }
};
struct EpiQ {
    static constexpr bool PERM = true, AFTER_DRAIN = false;
    bf16_t* O; const float* SS; const float* cvec;
    __device__ __forceinline__ void operator()(const f32x4 (&acc)[2][2][4][2], const Unit& u, int wr, int wc, int fr, int fq) const {
        const int row0 = u.pm * BM + wr * 64 + fr, col0 = u.pn * BM + wc * 32 + 8 * fq;
        const int b = (u.pm * BM) >> 11, ln = fr + 16 * fq;
        f32x4 cv[2][2];
#pragma unroll
        for (int bj = 0; bj < 2; ++bj)
#pragma unroll
            for (int n = 0; n < 2; ++n) cv[bj][n] = *(const f32x4*)(cvec + (size_t)b * 1024 + col0 + bj * HALF + 4 * n);
#pragma unroll
        for (int ai = 0; ai < 2; ++ai)
#pragma unroll
            for (int m = 0; m < 4; ++m) { const int row = row0 + ai * HALF + m * 16;
                const f32x4 pv = *(const f32x4*)(SS + (size_t)row * 16 + 4 * fq);
                float sq = (pv[0] + pv[1]) + (pv[2] + pv[3]); sq += lane_xchg(sq, ln ^ 16); sq += lane_xchg(sq, ln ^ 32);
                const float rs = __builtin_amdgcn_rsqf(sq * (1.f / 1024.f) + 1e-6f);
                bf16_t* rowp = O + (size_t)row * 1024 + col0;
#pragma unroll
                for (int bj = 0; bj < 2; ++bj) { const f32x4 v0 = acc[ai][bj][m][0] * rs + cv[bj][0], v1 = acc[ai][bj][m][1] * rs + cv[bj][1];
                    u32x4 w; w.x = cvt_pk_bf16(v0[0], v0[1]); w.y = cvt_pk_bf16(v0[2], v0[3]); w.z = cvt_pk_bf16(v1[0], v1[1]); w.w = cvt_pk_bf16(v1[2], v1[3]);
                    *(u32x4*)(rowp + bj * HALF) = w; } }
    }
};
struct EpiVT {
    static constexpr bool PERM = true, AFTER_DRAIN = false;
    bf16_t* O;
    __device__ __forceinline__ void operator()(const f32x4 (&acc)[2][2][4][2], const Unit& u, int wr, int wc, int fr, int fq) const {
        const int row0 = u.pm * BM + wr * 64 + fr, col0 = u.pn * BM + wc * 32 + 8 * fq;
#pragma unroll
        for (int ai = 0; ai < 2; ++ai)
#pragma unroll
            for (int m = 0; m < 4; ++m) { const int ch = row0 + ai * HALF + m * 16;
#pragma unroll
                for (int bj = 0; bj < 2; ++bj) { const f32x4 v0 = acc[ai][bj][m][0], v1 = acc[ai][bj][m][1];
                    u32x4 w; w.x = cvt_pk_bf16(v0[0], v0[1]); w.y = cvt_pk_bf16(v0[2], v0[3]); w.z = cvt_pk_bf16(v1[0], v1[1]); w.w = cvt_pk_bf16(v1[2], v1[3]);
                    const int tc = (col0 + bj * HALF) >> 3;
                    *(u32x4*)(O + ((size_t)tc * 512 + ch) * 8) = w; } }
    }
};
}

namespace mk {
#define GAS __attribute__((address_space(1)))
#define LAS __attribute__((address_space(3)))
typedef unsigned short bf16;
typedef unsigned v4u __attribute__((ext_vector_type(4)));
typedef unsigned v2u __attribute__((ext_vector_type(2)));
typedef int v4i __attribute__((ext_vector_type(4)));
typedef float f32x2 __attribute__((ext_vector_type(2)));
typedef float f32x4 __attribute__((ext_vector_type(4)));
typedef float f32x16 __attribute__((ext_vector_type(16)));
typedef short bf16x8 __attribute__((ext_vector_type(8)));
typedef short s16x4 __attribute__((ext_vector_type(4)));

constexpr int NWAVES = 8, NTHR = 512;
constexpr int BATCH = 16, SEQ = 2048, NT = BATCH * SEQ, DM = 1024, PCM = 2048, PCALL = 2560, MODW = 6144;
constexpr int PUV = 1024;
constexpr int NEXP = 16384;
constexpr int TROW = 1024;
constexpr int TROWV = TROW;
constexpr float EPSF = 1e-6f;
constexpr float STICK_T = 30.f;
constexpr size_t MiB = 1u << 20;
constexpr size_t WS_CTL = 0, CTL_ZERO_BYTES = 1 * MiB;
constexpr size_t WS_MOD = 1 * MiB;
constexpr size_t WS_WIN = 2 * MiB;
constexpr size_t WS_WOUT = 12 * MiB;
constexpr size_t WS_WQ = 16 * MiB;
constexpr size_t WS_SGU = 20 * MiB;
constexpr size_t WS_K12 = 20 * MiB + 512 * 1024;
constexpr size_t WS_SCL = 21 * MiB;
constexpr size_t WS_CHK = 21 * MiB + 512 * 1024;
constexpr size_t WS_U8 = 22 * MiB;
constexpr size_t WS_V8 = 54 * MiB;
constexpr size_t WS_XRES = 86 * MiB;
constexpr size_t WS_QI = 150 * MiB;
constexpr size_t WS_KI = 182 * MiB;
constexpr size_t WS_HB = 214 * MiB;
constexpr size_t WS_PROJ = 278 * MiB;
constexpr size_t WS_VT = 406 * MiB;
constexpr size_t WS_YMIX = 438 * MiB;
constexpr size_t WS_END = 511 * MiB;
constexpr size_t WS_WQS = 342 * MiB;
constexpr size_t WS_SS = WS_QI;
constexpr size_t WS_GS = 20 * MiB + 640 * 1024;
constexpr size_t WS_CVEC = 20 * MiB + 768 * 1024;
constexpr int CW_BAR = 4096;

constexpr int RING_BYTES = 131072, LDSCTL_OFF = RING_BYTES, MISC_OFF = LDSCTL_OFF + 320, LDS_BYTES = 147456;

__device__ __forceinline__ unsigned f2bf(float f) { unsigned u = __builtin_bit_cast(unsigned, f); return (u + 0x7fffu + ((u >> 16) & 1u)) >> 16; }
__device__ __forceinline__ unsigned pk2(float lo, float hi) { return f2bf(lo) | (f2bf(hi) << 16); }
__device__ __forceinline__ float bf2f(unsigned short b) { return __builtin_bit_cast(float, (unsigned)b << 16); }
__device__ __forceinline__ float bflo(unsigned w) { return __builtin_bit_cast(float, w << 16); }
__device__ __forceinline__ float bfhi(unsigned w) { return __builtin_bit_cast(float, w & 0xffff0000u); }
#ifndef RES_BF16
#define RES_BF16 1
#endif
typedef bf16 res_t;
__device__ __forceinline__ f32x4 ld4(const float* row, int i) { return ((const f32x4*)row)[i]; }
__device__ __forceinline__ f32x4 ld4(const bf16* row, int i) { const v2u w = ((const v2u*)row)[i]; return (f32x4){bflo(w.x), bfhi(w.x), bflo(w.y), bfhi(w.y)}; }
__device__ __forceinline__ void st4(float* row, int i, f32x4 v) { ((f32x4*)row)[i] = v; }
__device__ __forceinline__ void st4(bf16* row, int i, f32x4 v) { v2u w; w.x = pk2(v.x, v.y); w.y = pk2(v.z, v.w); ((v2u*)row)[i] = w; }
__device__ __forceinline__ int lane_now() { int l = (int)__builtin_amdgcn_mbcnt_hi(~0u, __builtin_amdgcn_mbcnt_lo(~0u, 0u)); asm volatile("" : "+v"(l)); return l; }
__device__ __forceinline__ float shx(float v, int k) { return __builtin_bit_cast(float, __builtin_amdgcn_ds_bpermute((lane_now() ^ k) << 2, __builtin_bit_cast(int, v))); }
__device__ __forceinline__ int shi(int v, int src) { return __builtin_amdgcn_ds_bpermute(src << 2, v); }
__device__ __forceinline__ float shf(float v, int src) { return __builtin_bit_cast(float, __builtin_amdgcn_ds_bpermute(src << 2, __builtin_bit_cast(int, v))); }
__device__ __forceinline__ float wave_sum(float v) {
#pragma unroll
    for (int o = 1; o < 64; o <<= 1) v += shx(v, o);
    return v;
}
__device__ __forceinline__ float wave_max(float v) {
#pragma unroll
    for (int o = 1; o < 64; o <<= 1) v = fmaxf(v, shx(v, o));
    return v;
}
__device__ __forceinline__ float silu_f(float x) { return x / (1.f + __expf(-x)); }
__device__ __forceinline__ float softplus_fast(float z) {
    const float e = __builtin_amdgcn_exp2f(-fabsf(z) * 1.4426950408889634f);
    return fmaxf(z, 0.f) + __builtin_amdgcn_logf(1.f + e) * 0.6931471805599453f;
}
__device__ __forceinline__ float exp_fast(float x) { return __builtin_amdgcn_exp2f(x * 1.4426950408889634f); }

#define XB_TMO      128
#define XB_XCNT(j)  (256  + 64 * (j))
#define XB_XSUB(j)  (1280 + 64 * (j))
#define XB_XGEN(j)  (2304 + 64 * (j))
#define XB_TOP      3328
#define XB_TOPGEN   3392
#define XCD_BAR_WORDS 3456
#define XB_SPIN_CAP (1u << 18)

__device__ __forceinline__ unsigned xb_ld(unsigned* p)              { return __hip_atomic_load(p, __ATOMIC_RELAXED, __HIP_MEMORY_SCOPE_AGENT); }
__device__ __forceinline__ unsigned xb_add(unsigned* p, unsigned v) { return __hip_atomic_fetch_add(p, v, __ATOMIC_RELAXED, __HIP_MEMORY_SCOPE_AGENT); }
__device__ __forceinline__ unsigned xb_xcc_id() { return (unsigned)__builtin_amdgcn_s_getreg((3 << 11) | 20) & 0xFu; }
#define XB_SPIN(cond, bar) do { unsigned _sp = 0; while (cond) { __builtin_amdgcn_s_sleep(1); \
    if ((++_sp & 255u) == 0u) { if (xb_ld(&(bar)[XB_TMO])) break; if (_sp > XB_SPIN_CAP) { atomicAdd(&(bar)[XB_TMO], 1u); break; } } } } while (0)

struct XcdBarrier {
    unsigned* bar; unsigned x;
    volatile LAS unsigned* st;
};

__device__ __forceinline__ XcdBarrier xcd_barrier_post(unsigned* bar, volatile LAS unsigned* st) {
    XcdBarrier b; b.bar = bar; b.x = xb_xcc_id(); b.st = st;
    if (threadIdx.x == 0) (void)xb_add(&bar[XB_XCNT(b.x)], 1u);
    return b;
}
__device__ __forceinline__ void xcd_barrier_complete(unsigned* bar, unsigned x, unsigned& nloc, unsigned& nx) {
    const unsigned G = gridDim.x * gridDim.y * gridDim.z;
    unsigned sum, cnt, mine, sp = 0u;
    for (;;) {
        sum = 0u; cnt = 0u; mine = 0u;
#pragma unroll
        for (unsigned j = 0; j < 16; ++j) { const unsigned c = xb_ld(&bar[XB_XCNT(j)]); sum += c; cnt += (c > 0u) ? 1u : 0u; mine = (j == x) ? c : mine; }
        if (sum == G) break;
        __builtin_amdgcn_s_sleep(1);
        if ((++sp & 255u) == 0u) { if (xb_ld(&bar[XB_TMO])) break; if (sp > XB_SPIN_CAP) { atomicAdd(&bar[XB_TMO], 1u); break; } }
    }
    nloc = mine > 0u ? mine : 1u; nx = cnt > 0u ? cnt : 1u;
}

__device__ __forceinline__ void xcd_barrier(const XcdBarrier& b) {
    asm volatile("s_waitcnt vmcnt(0)" ::: "memory");
    __syncthreads();
    if (threadIdx.x == 0) {
        unsigned* bar = b.bar;
        __builtin_amdgcn_s_waitcnt(0);
        unsigned nloc = b.st[0], nx = b.st[1];
        if (nloc == 0u) { xcd_barrier_complete(bar, b.x, nloc, nx); b.st[0] = nloc; b.st[1] = nx; }
        const unsigned old = xb_add(&bar[XB_XSUB(b.x)], 1u);
        const unsigned gen = old / nloc;
        if (old + 1u == (gen + 1u) * nloc) {
            __builtin_amdgcn_fence(__ATOMIC_RELEASE, "agent");
            asm volatile("s_waitcnt vmcnt(0)" ::: "memory");
            const unsigned og = xb_add(&bar[XB_TOP], 1u);
            const unsigned tg = og / nx;
            if (og + 1u == (tg + 1u) * nx) xb_add(&bar[XB_TOPGEN], 1u);
            else XB_SPIN(xb_ld(&bar[XB_TOPGEN]) == tg, bar);
            __builtin_amdgcn_fence(__ATOMIC_ACQUIRE, "agent");
            xb_add(&bar[XB_XGEN(b.x)], 1u);
            asm volatile("s_waitcnt vmcnt(0)" ::: "memory");
        } else {
            XB_SPIN(xb_ld(&bar[XB_XGEN(b.x)]) == gen, bar);
            __builtin_amdgcn_fence(__ATOMIC_ACQUIRE, "agent");
            asm volatile("s_waitcnt vmcnt(0)" ::: "memory");
        }
    }
    __syncthreads();
}

struct Ctx {
    LAS unsigned char* lds;
    int tid, lane, wave, G, vcu, gw, NGW;
    unsigned char* ws;
};

__device__ __forceinline__ void p0_transpose_item(const float* W, int K, int N, bf16* WT, LAS float* scr, int item, int lane) {
    const int nblk = N / 32, kb = item / nblk, nb = item % nblk, k0 = 64 * kb, n0 = 32 * nb;
#pragma unroll 8
    for (int i = 0; i < 32; ++i) { const int kk = 2 * i + (lane >> 5); scr[kk * 33 + (lane & 31)] = W[(size_t)(k0 + kk) * N + n0 + (lane & 31)]; }
    asm volatile("s_waitcnt lgkmcnt(0)" ::: "memory");
    const int c = lane & 7;
#pragma unroll
    for (int j = 0; j < 4; ++j) { const int n = (lane >> 3) + 8 * j; const LAS float* s = scr + (8 * c) * 33 + n;
        v4u o; o.x = pk2(s[0 * 33], s[1 * 33]); o.y = pk2(s[2 * 33], s[3 * 33]); o.z = pk2(s[4 * 33], s[5 * 33]); o.w = pk2(s[6 * 33], s[7 * 33]);
        *(v4u*)(WT + (size_t)(n0 + n) * K + k0 + 8 * c) = o; }
    asm volatile("s_waitcnt lgkmcnt(0)" ::: "memory");
}

template <class TI> __device__ __forceinline__ void norm_row_bf16(const TI* xrow, const float* g, const float* sh, const float* sc, bf16* orow, int lane) {
    f32x4 v[4]; float ss = 0.f;
#pragma unroll
    for (int j = 0; j < 4; ++j) { v[j] = ld4(xrow, lane + 64 * j); ss += (v[j].x * v[j].x + v[j].y * v[j].y) + (v[j].z * v[j].z + v[j].w * v[j].w); }
    const float rs = rsqrtf(wave_sum(ss) * (1.f / DM) + EPSF);
#pragma unroll
    for (int j = 0; j < 4; ++j) {
        const f32x4 gg = ((const f32x4*)g)[lane + 64 * j], s1 = ((const f32x4*)sc)[lane + 64 * j], s0 = ((const f32x4*)sh)[lane + 64 * j];
        const f32x4 o = v[j] * rs * gg * (s1 + 1.f) + s0;
        v2u w; w.x = pk2(o.x, o.y); w.y = pk2(o.z, o.w);
        ((v2u*)orow)[lane + 64 * j] = w;
    }
}

template <class TI> __device__ __forceinline__ void norm_rows2_bf16(const TI* xa, const TI* xb, const float* g, const float* sha, const float* sca, const float* shb, const float* scb, bf16* oa, bf16* ob, int lane) {
    f32x4 va[4], vb[4]; float sa = 0.f, sb = 0.f;
#pragma unroll
    for (int j = 0; j < 4; ++j) { va[j] = ld4(xa, lane + 64 * j); vb[j] = ld4(xb, lane + 64 * j); }
#pragma unroll
    for (int j = 0; j < 4; ++j) { sa += (va[j].x * va[j].x + va[j].y * va[j].y) + (va[j].z * va[j].z + va[j].w * va[j].w); sb += (vb[j].x * vb[j].x + vb[j].y * vb[j].y) + (vb[j].z * vb[j].z + vb[j].w * vb[j].w); }
#pragma unroll
    for (int o = 1; o < 64; o <<= 1) { sa += shx(sa, o); sb += shx(sb, o); }
    const float ra = rsqrtf(sa * (1.f / DM) + EPSF), rb = rsqrtf(sb * (1.f / DM) + EPSF);
#pragma unroll
    for (int j = 0; j < 4; ++j) {
        const f32x4 gg = ((const f32x4*)g)[lane + 64 * j];
        { const f32x4 s1 = ((const f32x4*)sca)[lane + 64 * j], s0 = ((const f32x4*)sha)[lane + 64 * j]; const f32x4 o = va[j] * ra * gg * (s1 + 1.f) + s0; v2u w; w.x = pk2(o.x, o.y); w.y = pk2(o.z, o.w); ((v2u*)oa)[lane + 64 * j] = w; }
        { const f32x4 s1 = ((const f32x4*)scb)[lane + 64 * j], s0 = ((const f32x4*)shb)[lane + 64 * j]; const f32x4 o = vb[j] * rb * gg * (s1 + 1.f) + s0; v2u w; w.x = pk2(o.x, o.y); w.y = pk2(o.z, o.w); ((v2u*)ob)[lane + 64 * j] = w; }
    }
}

__device__ __forceinline__ void table_row_i8(const float* src, unsigned char* dst, float* inv_scale, int lane) {
    f32x4 v[4]; float mx = 0.f;
#pragma unroll
    for (int j = 0; j < 4; ++j) { v[j] = ((const f32x4*)src)[lane + 64 * j]; mx = fmaxf(mx, fmaxf(fmaxf(fabsf(v[j].x), fabsf(v[j].y)), fmaxf(fabsf(v[j].z), fabsf(v[j].w)))); }
    mx = wave_max(mx);
    const float scale = (mx > 1e-30f) ? 127.f / mx : 0.f, inv = (mx > 1e-30f) ? mx * (1.f / 127.f) : 0.f;
    v4u o;
#pragma unroll
    for (int j = 0; j < 4; ++j) {
        const int a = (int)rintf(v[j].x * scale), b = (int)rintf(v[j].y * scale), c = (int)rintf(v[j].z * scale), d = (int)rintf(v[j].w * scale);
        o[j] = ((unsigned)a & 255u) | (((unsigned)b & 255u) << 8) | (((unsigned)c & 255u) << 16) | (((unsigned)d & 255u) << 24); }
    ((v4u*)dst)[lane] = o;
    if (lane == 0) *inv_scale = inv;
}
__device__ __forceinline__ void table_row_i4(const float* src, unsigned char* dst, float* inv_scale, int lane) {
    f32x4 v[4]; float mx = 0.f;
#pragma unroll
    for (int j = 0; j < 4; ++j) { v[j] = ((const f32x4*)src)[lane + 64 * j]; mx = fmaxf(mx, fmaxf(fmaxf(fabsf(v[j].x), fabsf(v[j].y)), fmaxf(fabsf(v[j].z), fabsf(v[j].w)))); }
    mx = wave_max(mx);
    const float scale = (mx > 1e-30f) ? 7.f / mx : 0.f, inv = (mx > 1e-30f) ? mx * (1.f / 7.f) : 0.f;
    v2u o;
#pragma unroll
    for (int c = 0; c < 2; ++c) { unsigned w = 0;
#pragma unroll
        for (int i = 0; i < 4; ++i) { const int ql = (int)rintf(v[2 * c][i] * scale), qh = (int)rintf(v[2 * c + 1][i] * scale);
            w |= ((((unsigned)qh & 15u) << 4) | ((unsigned)(ql + 8) & 15u)) << (8 * i); }
        o[c] = w; }
    ((v2u*)dst)[lane] = o;
    if (lane == 0) *inv_scale = inv;
}

__device__ __forceinline__ bf16x8 pack8(const float* a) {
    v4u w; w.x = pk2(a[0], a[1]); w.y = pk2(a[2], a[3]); w.z = pk2(a[4], a[5]); w.w = pk2(a[6], a[7]);
    return __builtin_bit_cast(bf16x8, w);
}
__device__ __forceinline__ void attn_item(const bf16* QI, const bf16* KI, const bf16* VT, bf16* YMIX, const float* onb, int b, int hd, int qb, int lane) {
    const int n = lane & 31, h = lane >> 5;
    const size_t rowbase = (size_t)b * SEQ;
    const int t0 = qb * 32;
    bf16x8 qf[4];
    { const bf16* qp = QI + (((size_t)((rowbase + t0) >> 5) * 8 + hd) * 8 + h) * 256 + n * 8;
#pragma unroll
      for (int ks = 0; ks < 4; ++ks) qf[ks] = *(const bf16x8*)(qp + ks * 512); }
    const bf16* kbase = KI + (((size_t)(rowbase >> 5) * 8 + hd) * 8 + h) * 256 + n * 8;
    const bf16* vbase = VT + ((size_t)(rowbase >> 3) * 512 + hd * 64 + n) * 8 + (size_t)h * 512 * 8;
    f32x16 o0, o1;
#pragma unroll
    for (int i = 0; i < 16; ++i) { o0[i] = 0.f; o1[i] = 0.f; }
    float R = 0.f;
#define ATT_LOAD(kf_, va0_, va1_, j_) do { const bf16* kp_ = kbase + (size_t)(j_) * 16384; const bf16* vp_ = vbase + (size_t)(4 * (j_)) * 4096; \
        _Pragma("unroll") for (int ks = 0; ks < 4; ++ks) kf_[ks] = *(const bf16x8*)(kp_ + ks * 512); \
        _Pragma("unroll") for (int s_ = 0; s_ < 2; ++s_) { va0_[s_] = *(const bf16x8*)(vp_ + (size_t)(2 * s_) * 4096); va1_[s_] = *(const bf16x8*)(vp_ + (size_t)(2 * s_) * 4096 + 256); } } while (0)
#define ATT_BLOCK(kf_, va0_, va1_, j_) do { \
        f32x16 sacc; _Pragma("unroll") for (int i = 0; i < 16; ++i) sacc[i] = 0.f; \
        _Pragma("unroll") for (int ks = 0; ks < 4; ++ks) sacc = __builtin_amdgcn_mfma_f32_32x32x16_bf16(kf_[ks], qf[ks], sacc, 0, 0, 0); \
        const bool diag = ((j_) == qb); float sp[16], zz[16]; \
        _Pragma("unroll") for (int i = 0; i < 16; ++i) { const float z = sacc[i] * 0.125f; const int key = (i & 7) + 8 * h + 16 * (i >> 3); const bool valid = (!diag) || (key < n); \
            const float s_ = softplus_fast(z); sp[i] = valid ? s_ : 0.f; zz[i] = z; } \
        float g0_ = 0.f, g1_ = 0.f; _Pragma("unroll") for (int i = 0; i < 8; ++i) { g0_ += sp[i]; g1_ += sp[8 + i]; } \
        const float p0_ = shx(g0_, 32), p1_ = shx(g1_, 32); \
        float a[16]; \
        { float suf = (h == 0 ? p1_ : 0.f);                                     \
          _Pragma("unroll") for (int e = 7; e >= 0; --e) { const int i = 8 + e; const int key = e + 8 * h + 16; const bool valid = (!diag) || (key < n); \
              a[i] = valid ? exp_fast((zz[i] - sp[i]) + (R - suf)) : 0.f; suf += sp[i]; } } \
        { float suf = (h == 0 ? p0_ : 0.f) + g1_ + p1_;                         \
          _Pragma("unroll") for (int e = 7; e >= 0; --e) { const int i = e; const int key = e + 8 * h; const bool valid = (!diag) || (key < n); \
              a[i] = valid ? exp_fast((zz[i] - sp[i]) + (R - suf)) : 0.f; suf += sp[i]; } } \
        R -= (g0_ + p0_) + (g1_ + p1_); \
        const bf16x8 pf0 = pack8(a), pf1 = pack8(a + 8); \
        o0 = __builtin_amdgcn_mfma_f32_32x32x16_bf16(va0_[0], pf0, o0, 0, 0, 0); \
        o0 = __builtin_amdgcn_mfma_f32_32x32x16_bf16(va0_[1], pf1, o0, 0, 0, 0); \
        o1 = __builtin_amdgcn_mfma_f32_32x32x16_bf16(va1_[0], pf0, o1, 0, 0, 0); \
        o1 = __builtin_amdgcn_mfma_f32_32x32x16_bf16(va1_[1], pf1, o1, 0, 0, 0); } while (0)
    { bf16x8 kA[4], kB[4]; bf16x8 vA0[2], vA1[2], vB0[2], vB1[2];
      int j = qb;
      ATT_LOAD(kA, vA0, vA1, j);
      for (;;) {
          ATT_LOAD(kB, vB0, vB1, (j > 0 ? j - 1 : 0));
          ATT_BLOCK(kA, vA0, vA1, j);
          if (j == 0 || __all(R < -STICK_T)) break;
          --j;
          ATT_LOAD(kA, vA0, vA1, (j > 0 ? j - 1 : 0));
          ATT_BLOCK(kB, vB0, vB1, j);
          if (j == 0 || __all(R < -STICK_T)) break;
          --j;
      } }
#undef ATT_LOAD
#undef ATT_BLOCK
    float ss = 0.f;
#pragma unroll
    for (int i = 0; i < 16; ++i) ss += o0[i] * o0[i] + o1[i] * o1[i];
    ss += shx(ss, 32);
    const float rs = rsqrtf(ss * (1.f / 64.f) + EPSF);
    bf16* yp = YMIX + (rowbase + t0 + n) * DM + 512 + hd * 64 + 4 * h;
    const float* gp = onb + hd * 64 + 4 * h;
#pragma unroll
    for (int q = 0; q < 4; ++q) {
        const f32x4 g0 = *(const f32x4*)(gp + 8 * q), g1 = *(const f32x4*)(gp + 32 + 8 * q);
        v2u w0, w1;
        w0.x = pk2(o0[4 * q] * rs * g0.x, o0[4 * q + 1] * rs * g0.y); w0.y = pk2(o0[4 * q + 2] * rs * g0.z, o0[4 * q + 3] * rs * g0.w);
        w1.x = pk2(o1[4 * q] * rs * g1.x, o1[4 * q + 1] * rs * g1.y); w1.y = pk2(o1[4 * q + 2] * rs * g1.z, o1[4 * q + 3] * rs * g1.w);
        *(v2u*)(yp + 8 * q) = w0; *(v2u*)(yp + 32 + 8 * q) = w1;
    }
}

__device__ __forceinline__ void gmlp_unit(const Ctx& C, const bf16* PROJ, const bf16* SGUW_l, const float* bs_l, const float* ona_l, bf16* YMIX, int b, int c, int g,
                                          v4u r0, v4u r1, const bf16* next_vp, v4u& nr0, v4u& nr1) {
    const size_t R0 = (size_t)b * SEQ + c * 128;
    LAS unsigned short* vnT = (LAS unsigned short*)C.lds;
    LAS float* ssum = (LAS float*)(C.lds + 64 * 272);
    const int mb = C.wave & 1, tb = C.wave >> 1, n = C.lane & 31, h = C.lane >> 5;
    const int tt = C.tid >> 2, qd = C.tid & 3;
    const bf16* wp = SGUW_l + ((size_t)g * 128 + 32 * tb + n) * 128 + 8 * h;
    bf16x8 wf[8];
#pragma unroll
    for (int ks = 0; ks < 8; ++ks) wf[ks] = *(const bf16x8*)(wp + 16 * ks);
    const float bb = bs_l[g * 128 + 32 * tb + n];
    const bf16* up = PROJ + (R0 + 32 * tb + n) * PUV + g * 64 + 32 * mb + 4 * h;
    v2u uu[4];
#pragma unroll
    for (int q = 0; q < 4; ++q) uu[q] = *(const v2u*)(up + 8 * q);
    const float* op = ona_l + g * 64 + 32 * mb + 4 * h;
    f32x4 gg[4];
#pragma unroll
    for (int q = 0; q < 4; ++q) gg[q] = *(const f32x4*)(op + 8 * q);
    { float v[16];
#pragma unroll
      for (int e = 0; e < 4; ++e) { v[2 * e] = bflo(r0[e]); v[2 * e + 1] = bfhi(r0[e]); v[8 + 2 * e] = bflo(r1[e]); v[8 + 2 * e + 1] = bfhi(r1[e]); }
      nr0 = *(const v4u*)next_vp; nr1 = *(const v4u*)(next_vp + 8);
      float s = 0.f;
#pragma unroll
      for (int e = 0; e < 16; ++e) s += v[e];
      s += shx(s, 1); s += shx(s, 2);
      const float mu = s * (1.f / 64.f);
      float q = 0.f;
#pragma unroll
      for (int e = 0; e < 16; ++e) { const float d = v[e] - mu; q += d * d; }
      q += shx(q, 1); q += shx(q, 2);
      const float rstd = rsqrtf(q * (1.f / 64.f) + EPSF);
#pragma unroll
      for (int e = 0; e < 16; ++e) vnT[(16 * qd + e) * 136 + tt] = (unsigned short)f2bf((v[e] - mu) * rstd);
    }
    __syncthreads();
    f32x16 acc;
#pragma unroll
    for (int i = 0; i < 16; ++i) acc[i] = 0.f;
    const LAS unsigned char* ap = C.lds + (32 * mb + n) * 272 + 16 * h;
#pragma unroll
    for (int ks = 0; ks < 8; ++ks) {
        const bf16x8 af = *(const LAS bf16x8*)(ap + 32 * ks);
        acc = __builtin_amdgcn_mfma_f32_32x32x16_bf16(af, wf[ks], acc, 0, 0, 0);
    }
    float y[16]; float ss = 0.f;
#pragma unroll
    for (int q = 0; q < 4; ++q) {
        const float u0 = bflo(uu[q].x), u1 = bfhi(uu[q].x), u2 = bflo(uu[q].y), u3 = bfhi(uu[q].y);
        y[4 * q] = u0 * (acc[4 * q] + bb); y[4 * q + 1] = u1 * (acc[4 * q + 1] + bb); y[4 * q + 2] = u2 * (acc[4 * q + 2] + bb); y[4 * q + 3] = u3 * (acc[4 * q + 3] + bb);
#pragma unroll
        for (int e = 0; e < 4; ++e) ss += y[4 * q + e] * y[4 * q + e]; }
    ss += shx(ss, 32);
    if (h == 0) ssum[mb * 128 + 32 * tb + n] = ss;
    __syncthreads();
    const float tot = ssum[32 * tb + n] + ssum[128 + 32 * tb + n];
    const float rs = rsqrtf(tot * (1.f / 64.f) + EPSF);
    bf16* yp = YMIX + (R0 + 32 * tb + n) * DM + g * 64 + 32 * mb + 4 * h;
#pragma unroll
    for (int q = 0; q < 4; ++q) {
        v2u w; w.x = pk2(y[4 * q] * rs * gg[q].x, y[4 * q + 1] * rs * gg[q].y); w.y = pk2(y[4 * q + 2] * rs * gg[q].z, y[4 * q + 3] * rs * gg[q].w);
        *(v2u*)(yp + 8 * q) = w; }
}

__device__ __forceinline__ void gmlp_phase(const Ctx& C, const bf16* PROJ, const bf16* SGUW_l, const float* bs_l, const float* ona_l, bf16* YMIX) {
    constexpr int NU = BATCH * 16 * 8;
    if ((int)blockIdx.x >= NU) return;
    LAS unsigned short* vnT = (LAS unsigned short*)C.lds;
    LAS float* ssum = (LAS float*)(C.lds + 64 * 272);
    const int mb = C.wave & 1, tb = C.wave >> 1, n = C.lane & 31, h = C.lane >> 5;
    const int tt = C.tid >> 2, qd = C.tid & 3;
    auto vptr = [&](int u) { const int g = u & 7, c = (u >> 3) & 15, b = u >> 7; return PROJ + ((size_t)b * SEQ + c * 128 + tt) * PUV + 512 + g * 64 + 16 * qd; };
    auto uptr = [&](int u) { const int g = u & 7, c = (u >> 3) & 15, b = u >> 7; return PROJ + ((size_t)b * SEQ + c * 128 + 32 * tb + n) * PUV + g * 64 + 32 * mb + 4 * h; };
    int u = blockIdx.x, g_cur = u & 7;
    bf16x8 wf[8]; float bb; f32x4 gg[4];
#define GMLP_LOAD_G(g_) do { const bf16* wp_ = SGUW_l + ((size_t)(g_) * 128 + 32 * tb + n) * 128 + 8 * h; \
        _Pragma("unroll") for (int ks = 0; ks < 8; ++ks) wf[ks] = *(const bf16x8*)(wp_ + 16 * ks); \
        bb = bs_l[(g_) * 128 + 32 * tb + n]; const float* op_ = ona_l + (g_) * 64 + 32 * mb + 4 * h; \
        _Pragma("unroll") for (int q = 0; q < 4; ++q) gg[q] = *(const f32x4*)(op_ + 8 * q); } while (0)
    GMLP_LOAD_G(g_cur);
    v4u r0, r1; v2u uu[4];
    { const bf16* vp = vptr(u); r0 = *(const v4u*)vp; r1 = *(const v4u*)(vp + 8); const bf16* up = uptr(u);
#pragma unroll
      for (int q = 0; q < 4; ++q) uu[q] = *(const v2u*)(up + 8 * q); }
    for (; u < NU; u += C.G) {
        const int g = u & 7, c = (u >> 3) & 15, b = u >> 7;
        if (g != g_cur) { GMLP_LOAD_G(g); g_cur = g; }
        const size_t R0 = (size_t)b * SEQ + c * 128;
        const int un = (u + C.G < NU) ? u + C.G : u;
        v4u nr0, nr1; v2u nuu[4];
        { float v[16];
#pragma unroll
          for (int e = 0; e < 4; ++e) { v[2 * e] = bflo(r0[e]); v[2 * e + 1] = bfhi(r0[e]); v[8 + 2 * e] = bflo(r1[e]); v[8 + 2 * e + 1] = bfhi(r1[e]); }
          { const bf16* vp = vptr(un); nr0 = *(const v4u*)vp; nr1 = *(const v4u*)(vp + 8); const bf16* up = uptr(un);
#pragma unroll
            for (int q = 0; q < 4; ++q) nuu[q] = *(const v2u*)(up + 8 * q); }
          float s = 0.f;
#pragma unroll
          for (int e = 0; e < 16; ++e) s += v[e];
          s += shx(s, 1); s += shx(s, 2);
          const float mu = s * (1.f / 64.f);
          float q = 0.f;
#pragma unroll
          for (int e = 0; e < 16; ++e) { const float d = v[e] - mu; q += d * d; }
          q += shx(q, 1); q += shx(q, 2);
          const float rstd = rsqrtf(q * (1.f / 64.f) + EPSF);
#pragma unroll
          for (int e = 0; e < 16; ++e) vnT[(16 * qd + e) * 136 + tt] = (unsigned short)f2bf((v[e] - mu) * rstd);
        }
        __syncthreads();
        f32x16 acc;
#pragma unroll
        for (int i = 0; i < 16; ++i) acc[i] = 0.f;
        const LAS unsigned char* ap = C.lds + (32 * mb + n) * 272 + 16 * h;
#pragma unroll
        for (int ks = 0; ks < 8; ++ks) {
            const bf16x8 af = *(const LAS bf16x8*)(ap + 32 * ks);
            acc = __builtin_amdgcn_mfma_f32_32x32x16_bf16(af, wf[ks], acc, 0, 0, 0);
        }
        float y[16]; float ss = 0.f;
#pragma unroll
        for (int q = 0; q < 4; ++q) {
            const float u0 = bflo(uu[q].x), u1 = bfhi(uu[q].x), u2 = bflo(uu[q].y), u3 = bfhi(uu[q].y);
            y[4 * q] = u0 * (acc[4 * q] + bb); y[4 * q + 1] = u1 * (acc[4 * q + 1] + bb); y[4 * q + 2] = u2 * (acc[4 * q + 2] + bb); y[4 * q + 3] = u3 * (acc[4 * q + 3] + bb);
#pragma unroll
            for (int e = 0; e < 4; ++e) ss += y[4 * q + e] * y[4 * q + e]; }
        ss += shx(ss, 32);
        if (h == 0) ssum[mb * 128 + 32 * tb + n] = ss;
        __syncthreads();
        const float tot = ssum[32 * tb + n] + ssum[128 + 32 * tb + n];
        const float rs = rsqrtf(tot * (1.f / 64.f) + EPSF);
        bf16* yp = YMIX + (R0 + 32 * tb + n) * DM + g * 64 + 32 * mb + 4 * h;
#pragma unroll
        for (int q = 0; q < 4; ++q) {
            v2u w; w.x = pk2(y[4 * q] * rs * gg[q].x, y[4 * q + 1] * rs * gg[q].y); w.y = pk2(y[4 * q + 2] * rs * gg[q].z, y[4 * q + 3] * rs * gg[q].w);
            *(v2u*)(yp + 8 * q) = w; }
        r0 = nr0; r1 = nr1;
#pragma unroll
        for (int q = 0; q < 4; ++q) uu[q] = nuu[q];
    }
#undef GMLP_LOAD_G
}

__device__ __forceinline__ void ce_desc(float& a, float& b) { const float hi = fmaxf(a, b), lo = fminf(a, b); a = hi; b = lo; }
template <int K, int J> __device__ __forceinline__ void bstage(float (&v)[16]) {
#pragma unroll
    for (int i = 0; i < 16; ++i) { const int l = i ^ J; if (l > i) { if ((i & K) == 0) ce_desc(v[i], v[l]); else ce_desc(v[l], v[i]); } }
}
__device__ __forceinline__ void bitonic_merge_desc(float (&v)[16]) { bstage<16, 8>(v); bstage<16, 4>(v); bstage<16, 2>(v); bstage<16, 1>(v); }
__device__ __forceinline__ void sort16_desc(float (&v)[16]) {
    ce_desc(v[0], v[1]); ce_desc(v[2], v[3]); ce_desc(v[0], v[2]); ce_desc(v[1], v[3]); ce_desc(v[1], v[2]); ce_desc(v[4], v[5]); ce_desc(v[6], v[7]); ce_desc(v[4], v[6]); ce_desc(v[5], v[7]); ce_desc(v[5], v[6]); ce_desc(v[0], v[4]); ce_desc(v[2], v[6]); ce_desc(v[2], v[4]); ce_desc(v[1], v[5]); ce_desc(v[3], v[7]); ce_desc(v[3], v[5]); ce_desc(v[1], v[2]); ce_desc(v[3], v[4]); ce_desc(v[5], v[6]); ce_desc(v[8], v[9]); ce_desc(v[10], v[11]); ce_desc(v[8], v[10]); ce_desc(v[9], v[11]); ce_desc(v[9], v[10]); ce_desc(v[12], v[13]); ce_desc(v[14], v[15]); ce_desc(v[12], v[14]); ce_desc(v[13], v[15]); ce_desc(v[13], v[14]); ce_desc(v[8], v[12]); ce_desc(v[10], v[14]); ce_desc(v[10], v[12]); ce_desc(v[9], v[13]); ce_desc(v[11], v[15]); ce_desc(v[11], v[13]); ce_desc(v[9], v[10]); ce_desc(v[11], v[12]); ce_desc(v[13], v[14]); ce_desc(v[0], v[8]); ce_desc(v[4], v[12]); ce_desc(v[4], v[8]); ce_desc(v[2], v[10]); ce_desc(v[6], v[14]); ce_desc(v[6], v[10]); ce_desc(v[2], v[4]); ce_desc(v[6], v[8]); ce_desc(v[10], v[12]); ce_desc(v[1], v[9]); ce_desc(v[5], v[13]); ce_desc(v[5], v[9]); ce_desc(v[3], v[11]); ce_desc(v[7], v[15]); ce_desc(v[7], v[11]); ce_desc(v[3], v[5]); ce_desc(v[7], v[9]); ce_desc(v[11], v[13]); ce_desc(v[1], v[2]); ce_desc(v[3], v[4]); ce_desc(v[5], v[6]); ce_desc(v[7], v[8]); ce_desc(v[9], v[10]); ce_desc(v[11], v[12]); ce_desc(v[13], v[14]);
}
__device__ __forceinline__ void merge_top16(float (&L)[16], const float (&N)[16]) {
#pragma unroll
    for (int p = 0; p < 16; ++p) L[p] = fmaxf(L[p], N[15 - p]);
    bitonic_merge_desc(L);
}
__device__ __forceinline__ void insert_desc(float (&L)[16], float v) {
#pragma unroll
    for (int p = 0; p < 16; ++p) { const float hi = fmaxf(L[p], v); v = fminf(L[p], v); L[p] = hi; }
}
__device__ __forceinline__ float embed(float x, unsigned code, unsigned keep_mask) { return __builtin_bit_cast(float, (__builtin_bit_cast(unsigned, x) & keep_mask) | code); }

__device__ __forceinline__ void top16_scores(const bf16* qp  , const LAS unsigned char* kb  , int h, float (&L)[16]) {
    bf16x8 qf[4];
#pragma unroll
    for (int ks = 0; ks < 4; ++ks) qf[ks] = *(const bf16x8*)(qp + 16 * ks);
#pragma unroll
    for (int mbk = 0; mbk < 4; ++mbk) {
        bf16x8 kf[4];
#pragma unroll
        for (int ks = 0; ks < 4; ++ks) kf[ks] = *(const LAS bf16x8*)(kb + mbk * 32 * 144 + 32 * ks);
        f32x16 acc;
#pragma unroll
        for (int i = 0; i < 16; ++i) acc[i] = 0.f;
#pragma unroll
        for (int ks = 0; ks < 4; ++ks) acc = __builtin_amdgcn_mfma_f32_32x32x16_bf16(kf[ks], qf[ks], acc, 0, 0, 0);
        float N[16];
#pragma unroll
        for (int i = 0; i < 16; ++i) N[i] = embed(acc[i], (unsigned)(32 * mbk + (i & 3) + 8 * (i >> 2)) | (unsigned)(4 * h), ~127u);
        sort16_desc(N);
        if (mbk == 0) {
#pragma unroll
            for (int i = 0; i < 16; ++i) L[i] = N[i];
        } else merge_top16(L, N);
    }
    float Pn[16];
#pragma unroll
    for (int i = 0; i < 16; ++i) Pn[i] = shx(L[i], 32);
    merge_top16(L, Pn);
}
__device__ __forceinline__ unsigned lookup7(const unsigned (&p)[4], unsigned a) {
    const unsigned w = a >> 2;
    const unsigned d = (w == 0u) ? p[0] : (w == 1u) ? p[1] : (w == 2u) ? p[2] : p[3];
    return (d >> (8u * (a & 3u))) & 127u;
}
__device__ __forceinline__ void route_item(const bf16* QP, const LAS unsigned char* K1L, const LAS unsigned char* K2L, const float* su_l, const float* sv_l, int* IDX, float* GATE, float* SUA, int tokblk, int hh, int lane) {
    const int n = lane & 31, h = lane >> 5;
    const int tok = tokblk * 32 + n;
    const bf16* qp = QP + (size_t)tok * DM + hh * 128 + 8 * h;
    float L1[16], L2[16];
    top16_scores(qp, K1L + n * 144 + 16 * h, h, L1);
    top16_scores(qp + 64, K2L + n * 144 + 16 * h, h, L2);
    float Cc[16];
#pragma unroll
    for (int bq = 0; bq < 16; ++bq) Cc[bq] = embed(L1[0] + L2[bq], (unsigned)bq, ~255u);
    { float X[16];
#pragma unroll
      for (int i = 0; i < 8; ++i) X[7 - i] = embed(L1[1] + L2[i], 0x10u | (unsigned)i, ~255u);
#pragma unroll
      for (int i = 0; i < 8; ++i) X[8 + i] = embed(L1[8 + i] + L2[0], (unsigned)((8 + i) << 4), ~255u);
      bitonic_merge_desc(X);
      merge_top16(Cc, X); }
    { float Y[16];
      Y[0] = embed(L1[2] + L2[0], 0x20u, ~255u); Y[1] = embed(L1[2] + L2[1], 0x21u, ~255u); Y[2] = embed(L1[2] + L2[2], 0x22u, ~255u);
      Y[3] = embed(L1[2] + L2[3], 0x23u, ~255u); Y[4] = embed(L1[2] + L2[4], 0x24u, ~255u);
      Y[5] = embed(L1[3] + L2[0], 0x30u, ~255u); Y[6] = embed(L1[3] + L2[1], 0x31u, ~255u); Y[7] = embed(L1[3] + L2[2], 0x32u, ~255u); Y[8] = embed(L1[3] + L2[3], 0x33u, ~255u);
      Y[9] = embed(L1[4] + L2[0], 0x40u, ~255u); Y[10] = embed(L1[4] + L2[1], 0x41u, ~255u); Y[11] = embed(L1[4] + L2[2], 0x42u, ~255u);
      Y[12] = embed(L1[5] + L2[0], 0x50u, ~255u); Y[13] = embed(L1[5] + L2[1], 0x51u, ~255u);
      Y[14] = embed(L1[6] + L2[0], 0x60u, ~255u); Y[15] = embed(L1[6] + L2[1], 0x61u, ~255u);
      sort16_desc(Y);
      merge_top16(Cc, Y); }
    insert_desc(Cc, embed(L1[7] + L2[0], 0x70u, ~255u));
    insert_desc(Cc, embed(L1[7] + L2[1], 0x71u, ~255u));
    unsigned p1[4], p2[4];
#pragma unroll
    for (int w = 0; w < 4; ++w) {
        p1[w] = (__builtin_bit_cast(unsigned, L1[4 * w]) & 127u) | ((__builtin_bit_cast(unsigned, L1[4 * w + 1]) & 127u) << 8) | ((__builtin_bit_cast(unsigned, L1[4 * w + 2]) & 127u) << 16) | ((__builtin_bit_cast(unsigned, L1[4 * w + 3]) & 127u) << 24);
        p2[w] = (__builtin_bit_cast(unsigned, L2[4 * w]) & 127u) | ((__builtin_bit_cast(unsigned, L2[4 * w + 1]) & 127u) << 8) | ((__builtin_bit_cast(unsigned, L2[4 * w + 2]) & 127u) << 16) | ((__builtin_bit_cast(unsigned, L2[4 * w + 3]) & 127u) << 24);
    }
    const float m = Cc[0];
    float ex[16]; float sum = 0.f;
#pragma unroll
    for (int p = 0; p < 16; ++p) { ex[p] = exp_fast(Cc[p] - m); sum += ex[p]; }
    const float inv = 1.f / sum;
    const unsigned hmask = h ? 0xffffffffu : 0u;
    int ei[8]; float gv[8];
#pragma unroll
    for (int pp = 0; pp < 8; ++pp) {
        const unsigned cvb = (__builtin_bit_cast(unsigned, Cc[8 + pp]) & hmask) | (__builtin_bit_cast(unsigned, Cc[pp]) & ~hmask);
        const float ev = __builtin_bit_cast(float, (__builtin_bit_cast(unsigned, ex[8 + pp]) & hmask) | (__builtin_bit_cast(unsigned, ex[pp]) & ~hmask));
        const unsigned code = cvb & 255u;
        const unsigned i1 = lookup7(p1, code >> 4), i2 = lookup7(p2, code & 15u);
        ei[pp] = (int)(i1 * 128u + i2); gv[pp] = ev * inv;
    }
    float sq[8];
#pragma unroll
    for (int pp = 0; pp < 8; ++pp) { gv[pp] *= sv_l[ei[pp]]; sq[pp] = su_l[ei[pp]]; }
    int* ip = IDX + (size_t)tok * 128 + hh * 16 + 8 * h;
    float* gp = GATE + (size_t)tok * 128 + hh * 16 + 8 * h;
    float* sp = SUA + (size_t)tok * 128 + hh * 16 + 8 * h;
    *(v4i*)ip = (v4i){ei[0], ei[1], ei[2], ei[3]}; *(v4i*)(ip + 4) = (v4i){ei[4], ei[5], ei[6], ei[7]};
    *(f32x4*)gp = (f32x4){gv[0], gv[1], gv[2], gv[3]}; *(f32x4*)(gp + 4) = (f32x4){gv[4], gv[5], gv[6], gv[7]};
    *(f32x4*)sp = (f32x4){sq[0], sq[1], sq[2], sq[3]}; *(f32x4*)(sp + 4) = (f32x4){sq[4], sq[5], sq[6], sq[7]};
}

__device__ __forceinline__ float reduce16(float (&p)[16], int lane) {
    float r8[8], r4[4], r2[2];
    const bool b3 = (lane & 8) != 0, b2 = (lane & 4) != 0, b1 = (lane & 2) != 0, b0 = (lane & 1) != 0;
#pragma unroll
    for (int i = 0; i < 8; ++i) { const float keep = b3 ? p[i + 8] : p[i], send = b3 ? p[i] : p[i + 8]; r8[i] = keep + shx(send, 8); }
#pragma unroll
    for (int i = 0; i < 4; ++i) { const float keep = b2 ? r8[i + 4] : r8[i], send = b2 ? r8[i] : r8[i + 4]; r4[i] = keep + shx(send, 4); }
#pragma unroll
    for (int i = 0; i < 2; ++i) { const float keep = b1 ? r4[i + 2] : r4[i], send = b1 ? r4[i] : r4[i + 2]; r2[i] = keep + shx(send, 2); }
    float r = (b0 ? r2[1] : r2[0]) + shx(b0 ? r2[0] : r2[1], 1);
    r += shx(r, 16); r += shx(r, 32);
    return r;
}
__device__ __forceinline__ void sort128(unsigned& a0, unsigned& a1, int lane) {
#pragma unroll
    for (int k2 = 2; k2 <= 128; k2 <<= 1) {
#pragma unroll
        for (int j2 = k2 >> 1; j2 > 0; j2 >>= 1) {
            const bool asc = ((2 * lane) & k2) == 0;
            if (j2 == 1) {
                const unsigned lo = a0 < a1 ? a0 : a1, hi = a0 < a1 ? a1 : a0;
                a0 = asc ? lo : hi; a1 = asc ? hi : lo;
            } else {
                const int lm = j2 >> 1;
                const bool takemin = (((lane & lm) == 0) == asc);
                const unsigned o0 = (unsigned)__builtin_amdgcn_ds_bpermute((lane ^ lm) << 2, (int)a0), o1 = (unsigned)__builtin_amdgcn_ds_bpermute((lane ^ lm) << 2, (int)a1);
                const unsigned mn0 = a0 < o0 ? a0 : o0, mx0 = a0 < o0 ? o0 : a0, mn1 = a1 < o1 ? a1 : o1, mx1 = a1 < o1 ? o1 : a1;
                a0 = takemin ? mn0 : mx0; a1 = takemin ? mn1 : mx1;
            }
        }
    }
}
struct ExpertArgs { int commit; const unsigned char* U8; const unsigned char* V8; const float* SUA; const int* IDX; const float* GATE;
                    res_t* XRES; const float* gt2; int last; float* out; const float* final_g; bf16* HB_out; const float* g_next; const float* sh_next; const float* sc_next; const float* gs2; const float* sh2; };
__device__ __forceinline__ void load_h2(const ExpertArgs& A, int tok, int lane, f32x2 (&hv)[8]) {
    const int b = tok >> 11; f32x4 xv[4]; float ss = 0.f;
#pragma unroll
    for (int j = 0; j < 4; ++j) { xv[j] = ld4((const res_t*)(A.XRES + (size_t)tok * DM), lane + 64 * j); ss += (xv[j].x * xv[j].x + xv[j].y * xv[j].y) + (xv[j].z * xv[j].z + xv[j].w * xv[j].w); }
    const float rs = rsqrtf(wave_sum(ss) * (1.f / DM) + EPSF);
#pragma unroll
    for (int j = 0; j < 4; ++j) { const f32x4 gg = ((const f32x4*)(A.gs2 + (size_t)b * DM))[lane + 64 * j], s0 = ((const f32x4*)(A.sh2 + (size_t)b * MODW))[lane + 64 * j];
        const f32x4 o = xv[j] * rs * gg + s0; hv[2 * j] = (f32x2){o.x, o.y}; hv[2 * j + 1] = (f32x2){o.z, o.w}; }
}

__device__ __forceinline__ void token_epilogue(const ExpertArgs& A, int tok, const int (&yi)[16], float cqs, int lane) {
    const int b = tok >> 11;
    f32x4 x2[4]; float ss = 0.f;
#pragma unroll
    for (int j = 0; j < 4; ++j) {
        const f32x4 xv = ld4((const res_t*)(A.XRES + (size_t)tok * DM), lane + 64 * j);
        const f32x4 gg = ((const f32x4*)(A.gt2 + (size_t)b * MODW))[lane + 64 * j];
        const f32x4 yy = {(float)yi[4 * j] * cqs, (float)yi[4 * j + 1] * cqs, (float)yi[4 * j + 2] * cqs, (float)yi[4 * j + 3] * cqs};
        x2[j] = xv + gg * yy;
        ss += (x2[j].x * x2[j].x + x2[j].y * x2[j].y) + (x2[j].z * x2[j].z + x2[j].w * x2[j].w);
    }
    const float rs = rsqrtf(wave_sum(ss) * (1.f / DM) + EPSF);
    if (!A.commit) { asm volatile("" :: "v"(rs)); return; }
    if (A.last) {
#pragma unroll
        for (int j = 0; j < 4; ++j) { const f32x4 gg = ((const f32x4*)A.final_g)[lane + 64 * j]; ((f32x4*)(A.out + (size_t)tok * DM))[lane + 64 * j] = x2[j] * rs * gg; }
    } else {
#pragma unroll
        for (int j = 0; j < 4; ++j) {
            st4(A.XRES + (size_t)tok * DM, lane + 64 * j, x2[j]);
            const f32x4 gg = ((const f32x4*)A.g_next)[lane + 64 * j], s1 = ((const f32x4*)(A.sc_next + (size_t)b * MODW))[lane + 64 * j], s0 = ((const f32x4*)(A.sh_next + (size_t)b * MODW))[lane + 64 * j];
            const f32x4 o = x2[j] * rs * gg * (s1 + 1.f) + s0;
            v2u w; w.x = pk2(o.x, o.y); w.y = pk2(o.z, o.w);
            ((v2u*)(A.HB_out + (size_t)tok * DM))[lane + 64 * j] = w;
        }
    }
}

template <int K> __device__ __forceinline__ int swz_xor(int v) { return __builtin_amdgcn_ds_swizzle(v, ((K & 31) << 10) | 0x1f); }
__device__ __forceinline__ int reduce8_i(const int (&p)[8], int lane, int a32) {
    int r4[4], r2[2];
    const bool b2 = (lane & 4) != 0, b1 = (lane & 2) != 0, b0 = (lane & 1) != 0;
#pragma unroll
    for (int i = 0; i < 4; ++i) { const int keep = b2 ? p[i + 4] : p[i], send = b2 ? p[i] : p[i + 4]; r4[i] = keep + swz_xor<4>(send); }
#pragma unroll
    for (int i = 0; i < 2; ++i) { const int keep = b1 ? r4[i + 2] : r4[i], send = b1 ? r4[i] : r4[i + 2]; r2[i] = keep + swz_xor<2>(send); }
    int r = (b0 ? r2[1] : r2[0]) + swz_xor<1>(b0 ? r2[0] : r2[1]);
    r += swz_xor<8>(r); r += swz_xor<16>(r); r += __builtin_amdgcn_ds_bpermute(a32, r);
    return r;
}
__device__ __forceinline__ int dot4_first(unsigned a, int b) { int d; asm("v_dot4_i32_i8 %0, %1, %2, 0" : "=v"(d) : "v"(a), "v"(b)); return d; }
__device__ __forceinline__ __amdgpu_buffer_rsrc_t make_rsrc(const void* p, unsigned bytes) {
    return __builtin_amdgcn_make_buffer_rsrc((void*)p, (short)0, (int)bytes, 0x00020000); }
template <int SYNTH> __device__ __forceinline__ void expert_rr4(const ExpertArgs& A, int tok0, int tstride, int lane) {
    asm volatile("" : "+v"(lane));
    const unsigned loff = (unsigned)lane << 4; const int a32 = (lane ^ 32) << 2, lg8 = lane >> 3;
    const __amdgpu_buffer_rsrc_t rsrcU = make_rsrc(A.U8, (unsigned)NEXP * 1024u), rsrcV = make_rsrc(A.V8, (unsigned)NEXP * (unsigned)TROWV);
    int S0[4], S1[4], hq[4][4], cpkf[4]; float G0[4], G1[4], Q0[4], Q1[4], c0[4], c1[4], hsc[4], cqs[4], csum[4]; int tk[4];
#pragma unroll
    for (int t = 0; t < 4; ++t) { const int tok = tok0 + t * tstride;
        f32x2 hv[8];
        load_h2(A, tok, lane, hv);
        int idx0 = A.IDX[(size_t)tok * 128 + lane], idx1 = A.IDX[(size_t)tok * 128 + 64 + lane];
        const float gt0 = A.GATE[(size_t)tok * 128 + lane], gt1 = A.GATE[(size_t)tok * 128 + 64 + lane];
        const float su0 = A.SUA[(size_t)tok * 128 + lane], su1 = A.SUA[(size_t)tok * 128 + 64 + lane];
        float mx = 0.f;
#pragma unroll
        for (int i = 0; i < 8; ++i) mx = fmaxf(mx, fmaxf(fabsf(hv[i].x), fabsf(hv[i].y)));
        mx = wave_max(mx);
        const float qs = (mx > 1e-30f) ? 127.f / mx : 0.f; hsc[t] = (mx > 1e-30f) ? mx * (1.f / 127.f) : 0.f;
#pragma unroll
        for (int j = 0; j < 4; ++j) { const int a = (int)rintf(hv[2 * j].x * qs), b = (int)rintf(hv[2 * j].y * qs), c = (int)rintf(hv[2 * j + 1].x * qs), d = (int)rintf(hv[2 * j + 1].y * qs);
            hq[t][j] = (int)(((unsigned)a & 255u) | (((unsigned)b & 255u) << 8) | (((unsigned)c & 255u) << 16) | (((unsigned)d & 255u) << 24)); }
        unsigned k0 = ((unsigned)idx0 << 7) | (unsigned)lane, k1 = ((unsigned)idx1 << 7) | (unsigned)(lane + 64);
        sort128(k0, k1, lane);
        S0[t] = (int)((k0 >> 7) << 10); S1[t] = (int)((k1 >> 7) << 10);
        const int p0 = (int)(k0 & 63u), p1 = (int)(k1 & 63u); const bool h0 = (k0 & 64u) != 0, h1 = (k1 & 64u) != 0;
        const float ga = shf(gt0, p0), gb = shf(gt1, p0), gc = shf(gt0, p1), gd = shf(gt1, p1);
        const float qa = shf(su0, p0), qb = shf(su1, p0), qc = shf(su0, p1), qd = shf(su1, p1);
        G0[t] = h0 ? gb : ga; G1[t] = h1 ? gd : gc; Q0[t] = h0 ? qb : qa; Q1[t] = h1 ? qd : qc;
        c0[t] = 0.f; c1[t] = 0.f; cpkf[t] = 0; cqs[t] = 0.f; csum[t] = 0.f; tk[t] = 0;
    }
    int yi[4][16];
#pragma unroll
    for (int t = 0; t < 4; ++t)
#pragma unroll
        for (int i = 0; i < 16; ++i) yi[t][i] = 0;
#define RR_ISSUE(slot0, t_, g_, tab_) do { const int lb_ = 4 * (g_); _Pragma("unroll") for (int j = 0; j < 8; ++j) { const int e_ = __builtin_amdgcn_readlane((j & 1) ? S1[t_] : S0[t_], lb_ + (j >> 1)); \
        if (SYNTH == 1) { v4u q_; q_[0] = (unsigned)(e_ * 0x01010101) ^ (unsigned)lane; q_[1] = (unsigned)e_ + (unsigned)lane; q_[2] = q_[0] * 3u; q_[3] = q_[1] * 5u; asm volatile("" : "+v"(q_)); ring[(slot0) + j] = q_; } \
        else ring[(slot0) + j] = __builtin_bit_cast(v4u, __builtin_amdgcn_raw_buffer_load_b128(rsrcU, (int)loff, e_, 0)); } __builtin_amdgcn_sched_barrier(0); } while (0)
#define RR_ISSUEV(slot0, t_, g_) do { const int lb_ = 4 * (g_); _Pragma("unroll") for (int j = 0; j < 8; ++j) { const int e_ = __builtin_amdgcn_readlane((j & 1) ? S1[t_] : S0[t_], lb_ + (j >> 1)); \
        if (SYNTH == 1) { v2u q_; q_[0] = (unsigned)(e_ * 0x01010101) ^ (unsigned)lane; q_[1] = (unsigned)e_ + (unsigned)lane; asm volatile("" : "+v"(q_)); ring[(slot0) + j][0] = q_.x; ring[(slot0) + j][1] = q_.y; } \
        else { const v2u w_ = __builtin_bit_cast(v2u, __builtin_amdgcn_raw_buffer_load_b64(rsrcV, (int)(loff >> 1), e_, 0)); ring[(slot0) + j][0] = w_.x; ring[(slot0) + j][1] = w_.y; } } } while (0)
#define RR_U(slot0, t_, g_) do { int p[8]; \
        _Pragma("unroll") for (int j = 7; j >= 0; --j) { int acc = dot4_first(ring[(slot0) + j][0], hq[t_][0]); _Pragma("unroll") for (int w = 1; w < 4; ++w) acc = __builtin_amdgcn_sdot4((int)ring[(slot0) + j][w], hq[t_][w], acc, false); p[j] = acc; }        \
        const int tt_ = reduce8_i(p, lane, a32); tk[t_] = (lg8 == ((g_) & 7)) ? tt_ : tk[t_]; __builtin_amdgcn_sched_barrier(0); } while (0)
#define RR_UW(t_, w_) do { const int src = (lane >> 1) + 32 * (w_); \
        const float gka = shf(G0[t_], src), gkb = shf(G1[t_], src), ska = shf(Q0[t_], src), skb = shf(Q1[t_], src); \
        const float gk = (lane & 1) ? gkb : gka, sk = (lane & 1) ? skb : ska; \
        const float val = pg8::gelu_tanh_f((float)tk[t_] * (sk * hsc[t_])) * gk; \
        const float v0_ = shf(val, 2 * (lane & 31)), v1_ = shf(val, 2 * (lane & 31) + 1); const bool mine = ((lane >> 5) == (w_)); \
        c0[t_] = mine ? v0_ : c0[t_]; c1[t_] = mine ? v1_ : c1[t_]; } while (0)
#define RR_MID(t_) do { const float cm_ = wave_max(fmaxf(fabsf(c0[t_]), fabsf(c1[t_]))); const float q_ = (cm_ > 1e-30f) ? 127.f / cm_ : 0.f; cqs[t_] = (cm_ > 1e-30f) ? cm_ * (1.f / 127.f) : 0.f; \
        const float qa_ = rintf(c0[t_] * q_), qb_ = rintf(c1[t_] * q_); if (V4) csum[t_] = wave_sum(qa_ + qb_); \
        const unsigned pk_ = ((unsigned)(int)qa_ & 255u) | (((unsigned)(int)qb_ & 255u) << 8); \
        const unsigned nb_ = (unsigned)__builtin_amdgcn_ds_bpermute(((lane + 1) & 63) << 2, (int)pk_); cpkf[t_] = (int)(pk_ | (nb_ << 16)); } while (0)
#define RR_V(slot0, t_, g_) do { const int lb_ = 4 * (g_); \
        _Pragma("unroll") for (int gq = 0; gq < 2; ++gq) { const int cpk = __builtin_amdgcn_readlane(cpkf[t_], lb_ + 2 * gq); \
            _Pragma("unroll") for (int c = 0; c < 2; ++c) { \
                const unsigned r0_ = ring[(slot0) + 4 * gq][c], r1_ = ring[(slot0) + 4 * gq + 1][c], r2_ = ring[(slot0) + 4 * gq + 2][c], r3_ = ring[(slot0) + 4 * gq + 3][c]; \
                const unsigned pa_ = __builtin_amdgcn_perm(r1_, r0_, 0x05010400u), pb_ = __builtin_amdgcn_perm(r1_, r0_, 0x07030602u); \
                const unsigned pc_ = __builtin_amdgcn_perm(r3_, r2_, 0x05010400u), pd_ = __builtin_amdgcn_perm(r3_, r2_, 0x07030602u); \
                const unsigned t0_ = __builtin_amdgcn_perm(pc_, pa_, 0x05040100u), t1_ = __builtin_amdgcn_perm(pc_, pa_, 0x07060302u), t2_ = __builtin_amdgcn_perm(pd_, pb_, 0x05040100u), t3_ = __builtin_amdgcn_perm(pd_, pb_, 0x07060302u); \
                yi[t_][4 * c + 0] = __builtin_amdgcn_sdot4((int)t0_, cpk, yi[t_][4 * c + 0], false); yi[t_][8 + 4 * c + 0] = __builtin_amdgcn_sdot4((int)(t0_ & 0x0f0f0f0fu), cpk, yi[t_][8 + 4 * c + 0], false); \
                yi[t_][4 * c + 1] = __builtin_amdgcn_sdot4((int)t1_, cpk, yi[t_][4 * c + 1], false); yi[t_][8 + 4 * c + 1] = __builtin_amdgcn_sdot4((int)(t1_ & 0x0f0f0f0fu), cpk, yi[t_][8 + 4 * c + 1], false); \
                yi[t_][4 * c + 2] = __builtin_amdgcn_sdot4((int)t2_, cpk, yi[t_][4 * c + 2], false); yi[t_][8 + 4 * c + 2] = __builtin_amdgcn_sdot4((int)(t2_ & 0x0f0f0f0fu), cpk, yi[t_][8 + 4 * c + 2], false); \
                yi[t_][4 * c + 3] = __builtin_amdgcn_sdot4((int)t3_, cpk, yi[t_][4 * c + 3], false); yi[t_][8 + 4 * c + 3] = __builtin_amdgcn_sdot4((int)(t3_ & 0x0f0f0f0fu), cpk, yi[t_][8 + 4 * c + 3], false); } \
            __builtin_amdgcn_sched_barrier(0); } } while (0)
    { v4u ring[24];
      RR_ISSUE(0, 0, 0, A.U8); RR_ISSUE(8, 1, 0, A.U8); RR_ISSUE(16, 2, 0, A.U8);
#pragma unroll 1
      for (int it = 0; it < 5; ++it) { const int gb = 3 * it;
          RR_U(0, 0, gb + 0); RR_ISSUE(0, 3, gb + 0, A.U8);
          RR_U(8, 1, gb + 0); RR_ISSUE(8, 0, gb + 1, A.U8);
          RR_U(16, 2, gb + 0); RR_ISSUE(16, 1, gb + 1, A.U8);
          RR_U(0, 3, gb + 0); RR_ISSUE(0, 2, gb + 1, A.U8);
          RR_U(8, 0, gb + 1); if (gb == 6) RR_UW(0, 0); RR_ISSUE(8, 3, gb + 1, A.U8);
          RR_U(16, 1, gb + 1); if (gb == 6) RR_UW(1, 0); RR_ISSUE(16, 0, gb + 2, A.U8);
          RR_U(0, 2, gb + 1); if (gb == 6) RR_UW(2, 0); RR_ISSUE(0, 1, gb + 2, A.U8);
          RR_U(8, 3, gb + 1); if (gb == 6) RR_UW(3, 0); RR_ISSUE(8, 2, gb + 2, A.U8);
          RR_U(16, 0, gb + 2); RR_ISSUE(16, 3, gb + 2, A.U8);
          RR_U(0, 1, gb + 2); RR_ISSUE(0, 0, gb + 3, A.U8);
          RR_U(8, 2, gb + 2); RR_ISSUE(8, 1, gb + 3, A.U8);
          RR_U(16, 3, gb + 2); RR_ISSUE(16, 2, gb + 3, A.U8);
          __builtin_amdgcn_s_barrier();
      }
      RR_U(0, 0, 15); RR_ISSUE(0, 3, 15, A.U8); RR_UW(0, 1);
      RR_U(8, 1, 15); RR_ISSUEV(8, 0, 0); RR_UW(1, 1);
      RR_U(16, 2, 15); RR_ISSUEV(16, 1, 0); RR_UW(2, 1);
      RR_U(0, 3, 15); RR_ISSUEV(0, 2, 0); RR_UW(3, 1);
      RR_MID(0); RR_MID(1); RR_MID(2); RR_MID(3);
#pragma unroll 1
      for (int it = 0; it < 5; ++it) { const int gb = 3 * it;
          RR_V(8, 0, gb + 0); RR_ISSUEV(8, 3, gb + 0);
          RR_V(16, 1, gb + 0); RR_ISSUEV(16, 0, gb + 1);
          RR_V(0, 2, gb + 0); RR_ISSUEV(0, 1, gb + 1);
          RR_V(8, 3, gb + 0); RR_ISSUEV(8, 2, gb + 1);
          RR_V(16, 0, gb + 1); RR_ISSUEV(16, 3, gb + 1);
          RR_V(0, 1, gb + 1); RR_ISSUEV(0, 0, gb + 2);
          RR_V(8, 2, gb + 1); RR_ISSUEV(8, 1, gb + 2);
          RR_V(16, 3, gb + 1); RR_ISSUEV(16, 2, gb + 2);
          RR_V(0, 0, gb + 2); RR_ISSUEV(0, 3, gb + 2);
          RR_V(8, 1, gb + 2); RR_ISSUEV(8, 0, gb + 3);
          RR_V(16, 2, gb + 2); RR_ISSUEV(16, 1, gb + 3);
          RR_V(0, 3, gb + 2); RR_ISSUEV(0, 2, gb + 3);
      }
      RR_V(8, 0, 15); RR_ISSUEV(8, 3, 15);
      RR_V(16, 1, 15);
      RR_V(0, 2, 15);
      RR_V(8, 3, 15);
    }
#undef RR_ISSUE
#undef RR_ISSUEV
#undef RR_U
#undef RR_UW
#undef RR_MID
#undef RR_V
    { unsigned pa_ = 0x07060504u, pb_ = 0x03020100u; asm volatile("" : "+v"(pa_), "+v"(pb_));
      if (__builtin_amdgcn_perm(pa_, pb_, 0x06020400u) != 0x06020400u) { cqs[0] = cqs[1] = cqs[2] = cqs[3] = __builtin_nanf(""); } }
#pragma unroll
    for (int t = 0; t < 4; ++t) { const int cs8 = 8 * (int)csum[t]; int yo[16];
#pragma unroll
        for (int c = 0; c < 2; ++c)
#pragma unroll
            for (int i = 0; i < 4; ++i) { const int raw = yi[t][4 * c + i], lo = yi[t][8 + 4 * c + i]; yo[4 * (2 * c) + i] = lo - cs8; yo[4 * (2 * c + 1) + i] = (raw - lo) >> 4; }
        token_epilogue(A, tok0 + t * tstride, yo, cqs[t], lane); }
}


struct Args { const float* in[18]; float* out; unsigned char* ws; int dbg; int pad; };

#define CAS __attribute__((address_space(4)))
__device__ __forceinline__ unsigned long long ld_ptr(int, int i) {
    const volatile CAS unsigned long long* p = (const volatile CAS unsigned long long*)__builtin_amdgcn_kernarg_segment_ptr();
    return p[i];
}
#define INP(i) ((const float*)(const GAS float*)ld_ptr(PT, (i)))
#define WSP() ((unsigned char*)(GAS unsigned char*)ld_ptr(PT, 19))
#define PHASE_CTX() do { int t_ = threadIdx.x; asm volatile("" : "+v"(t_)); C.tid = t_; C.lane = t_ & 63; C.wave = __builtin_amdgcn_readfirstlane(t_ >> 6); \
        int G_ = gridDim.x; asm volatile("" : "+s"(G_)); C.G = G_; const int bx_ = blockIdx.x; C.vcu = (G_ % 8 == 0) ? (bx_ % 8) * (G_ / 8) + bx_ / 8 : bx_; \
        C.gw = C.vcu * NWAVES + C.wave; C.NGW = G_ * NWAVES; C.lds = (LAS unsigned char*)lds_raw; } while (0)
#ifndef PHMASK
#define PHMASK 0xFFFF
#endif
#ifndef REPMASK
#define REPMASK 0
#endif
#define NREP(bit) (((REPMASK) & (bit)) ? 2 : 1)

__global__ void __launch_bounds__(NTHR, 2) mega_fwd(Args args) {
    extern __shared__ __attribute__((aligned(16))) unsigned char lds_raw[];
    Ctx C; C.ws = nullptr;
    PHASE_CTX();
    for (int u = C.tid; u < (LDS_BYTES - LDSCTL_OFF) / 4; u += NTHR) ((LAS unsigned*)(C.lds + LDSCTL_OFF))[u] = 0u;
    __syncthreads();
#define MISC ((volatile LAS unsigned*)((LAS unsigned char*)lds_raw + MISC_OFF))
#define PT 0
    (void)xcd_barrier_post((unsigned*)(WSP() + WS_CTL) + CW_BAR, MISC + 8);
#define GRID_BAR() do { XcdBarrier bar_; bar_.bar = (unsigned*)(WSP() + WS_CTL) + CW_BAR; bar_.x = xb_xcc_id(); bar_.st = MISC + 8; xcd_barrier(bar_); } while (0)


    for (int rep0 = 0; rep0 < NREP(1); ++rep0) {
    if constexpr ((PHMASK & 1) != 0) {
    PHASE_CTX();
    const float* cvec = INP(1); const float* ada_w = INP(2); const float* ada_b = INP(3); float* mod = (float*)(WSP() + WS_MOD);
    for (int it = blockIdx.x; it < 192; it += C.G) {
        const int l = it / 96, e0 = (it % 96) * 64;
        LAS float* cs = (LAS float*)C.lds;
        LAS float* red = (LAS float*)(C.lds + 65536);
        for (int i = C.tid; i < BATCH * DM; i += NTHR) cs[i] = silu_f(cvec[i]);
        __syncthreads();
        float acc[16];
#pragma unroll
        for (int bb = 0; bb < 16; ++bb) acc[bb] = 0.f;
        const float* wp = ada_w + ((size_t)l * DM + C.wave * 128) * MODW + e0 + C.lane;
        const LAS float* cp = cs + C.wave * 128;
#pragma unroll 8
        for (int d = 0; d < 128; ++d) { const float wv = wp[(size_t)d * MODW];
#pragma unroll
            for (int bb = 0; bb < 16; ++bb) acc[bb] += cp[bb * DM + d] * wv; }
#pragma unroll
        for (int bb = 0; bb < 16; ++bb) red[(C.wave * 16 + bb) * 64 + C.lane] = acc[bb];
        __syncthreads();
        for (int o = C.tid; o < 1024; o += NTHR) { const int bb = o >> 6, ln = o & 63; float s = ada_b[l * MODW + e0 + ln];
#pragma unroll
            for (int w8 = 0; w8 < 8; ++w8) s += red[(w8 * 16 + bb) * 64 + ln];
            mod[((size_t)l * BATCH + bb) * MODW + e0 + ln] = s; }
        __syncthreads();
    } }
    if constexpr ((PHMASK & 2) != 0) {
        PHASE_CTX(); unsigned char* ws = WSP();
        const float* w_in = INP(6); const float* w_out = INP(11); const float* peer_wq = INP(12);
        bf16* WIN_T = (bf16*)(ws + WS_WIN); bf16* WOUT_T = (bf16*)(ws + WS_WOUT); bf16* WQ_T = (bf16*)(ws + WS_WQ);
        LAS float* scr = (LAS float*)(C.lds + C.wave * 16384);
        for (int it = C.gw; it < 4608; it += C.NGW) {
            const int l = it / 2304; int r = it % 2304;
            if (r < 1280) { p0_transpose_item(w_in + (size_t)l * DM * PCALL, DM, PCALL, WIN_T + (size_t)l * PCALL * DM, scr, r, C.lane); continue; } r -= 1280;
            if (r < 512) { p0_transpose_item(w_out + (size_t)l * DM * DM, DM, DM, WOUT_T + (size_t)l * DM * DM, scr, r, C.lane); continue; } r -= 512;
            p0_transpose_item(peer_wq + (size_t)l * DM * DM, DM, DM, WQ_T + (size_t)l * DM * DM, scr, r, C.lane);
        }
        const float* sgu_w = INP(7); const float* peer_k1 = INP(13); const float* peer_k2 = INP(14);
        bf16* SGUW = (bf16*)(ws + WS_SGU); bf16* K1B = (bf16*)(ws + WS_K12); bf16* K2B = K1B + 2 * 128 * 64;
        const int gt = C.gw * 64 + C.lane, NGT = C.NGW * 64;
        for (int i = gt; i < 2 * 8 * 128 * 128; i += NGT) { const int s = i & 127, t = (i >> 7) & 127; SGUW[i] = (bf16)f2bf(s <= t ? sgu_w[i] : 0.f); }
        for (int i = gt; i < 2 * 128 * 64; i += NGT) { K1B[i] = (bf16)f2bf(peer_k1[i]); K2B[i] = (bf16)f2bf(peer_k2[i]); }
    }
    if constexpr ((PHMASK & 8) != 0) {
        PHASE_CTX(); unsigned char* ws = WSP(); const float* peer_u = INP(15); const float* peer_v = INP(16);
        float* SCLU = (float*)(ws + WS_SCL); float* SCLV = SCLU + 2 * NEXP; unsigned char* U8 = ws + WS_U8; unsigned char* V8 = ws + WS_V8;
        for (int r = C.gw; r < 4 * NEXP; r += C.NGW) { const int tab = r >> 15, rr = r & 32767;
            if (tab) table_row_i4(peer_v + (size_t)rr * DM, V8 + (size_t)rr * TROWV, SCLV + rr, C.lane);
            else table_row_i8(peer_u + (size_t)rr * DM, U8 + (size_t)rr * TROW, SCLU + rr, C.lane);
        } }
    __syncthreads(); }
    GRID_BAR();
    for (int rep0 = 0; rep0 < NREP(4); ++rep0) {
    if constexpr ((PHMASK & 4) != 0) {
        PHASE_CTX(); unsigned char* ws = WSP(); const float* x = INP(0); const float* norm1_g = INP(4); const float* mod = (const float*)(ws + WS_MOD); bf16* HB = (bf16*)(ws + WS_HB);
        for (int m = 2 * C.gw; m < NT; m += 2 * C.NGW) { const int m2 = m + 1; const int b = m >> 11, b2 = (m2 < NT ? m2 : m) >> 11;
            if (m2 < NT) norm_rows2_bf16(x + (size_t)m * DM, x + (size_t)m2 * DM, norm1_g, mod + (size_t)b * MODW, mod + (size_t)b * MODW + DM, mod + (size_t)b2 * MODW, mod + (size_t)b2 * MODW + DM, HB + (size_t)m * DM, HB + (size_t)m2 * DM, C.lane);
            else norm_row_bf16(x + (size_t)m * DM, norm1_g, mod + (size_t)b * MODW, mod + (size_t)b * MODW + DM, HB + (size_t)m * DM, C.lane); } }
    if constexpr ((PHMASK & 4) != 0) {
        PHASE_CTX(); unsigned char* ws = WSP(); const float* norm2_g = INP(5); const float* mod = (const float*)(ws + WS_MOD);
        const bf16* WQ_T = (const bf16*)(ws + WS_WQ); bf16* WQS = (bf16*)(ws + WS_WQS); float* GS = (float*)(ws + WS_GS); float* CV = (float*)(ws + WS_CVEC);
        for (int it = C.gw; it < 2 * DM; it += C.NGW) { const int l = it >> 10, n = it & 1023;
            f32x4 w[4];
#pragma unroll
            for (int j = 0; j < 4; ++j) w[j] = ld4(WQ_T + ((size_t)l * DM + n) * DM, C.lane + 64 * j) * ((const f32x4*)(norm2_g + l * DM))[C.lane + 64 * j];
#pragma unroll 4
            for (int b = 0; b < BATCH; ++b) { const float* sc = mod + ((size_t)l * BATCH + b) * MODW + 4 * DM; bf16* o = WQS + (((size_t)l * BATCH + b) * DM + n) * DM;
#pragma unroll
                for (int j = 0; j < 4; ++j) st4(o, C.lane + 64 * j, w[j] * (((const f32x4*)sc)[C.lane + 64 * j] + 1.f)); } }
        for (int it = C.gw; it < 2 * BATCH; it += C.NGW) { const int l = it >> 4, b = it & 15; const float* sc = mod + ((size_t)l * BATCH + b) * MODW + 4 * DM;
#pragma unroll
            for (int j = 0; j < 4; ++j) ((f32x4*)(GS + (size_t)it * DM))[C.lane + 64 * j] = ((const f32x4*)(norm2_g + l * DM))[C.lane + 64 * j] * (((const f32x4*)sc)[C.lane + 64 * j] + 1.f); }
        for (int it = C.gw; it < 2 * BATCH * 64; it += C.NGW) { const int l = it >> 10, b = (it >> 6) & 15, n0 = (it & 63) * 16; const float* sh = mod + ((size_t)l * BATCH + b) * MODW + 3 * DM;
            f32x4 s4[4]; float pr[16];
#pragma unroll
            for (int j = 0; j < 4; ++j) s4[j] = ((const f32x4*)sh)[C.lane + 64 * j];
#pragma unroll
            for (int nn = 0; nn < 16; ++nn) { float a = 0.f;
#pragma unroll
                for (int j = 0; j < 4; ++j) { const f32x4 wv = ld4(WQ_T + ((size_t)l * DM + n0 + nn) * DM, C.lane + 64 * j); a += (wv.x * s4[j].x + wv.y * s4[j].y) + (wv.z * s4[j].z + wv.w * s4[j].w); }
                pr[nn] = a; }
            const float r = reduce16(pr, C.lane);
            if (C.lane < 16) CV[((size_t)l * BATCH + b) * DM + n0 + C.lane] = r; } }
    __syncthreads(); }
    GRID_BAR();

#pragma unroll
    for (int l = 0; l < 2; ++l) {
        for (int rep = 0; rep < NREP(16); ++rep) {
        if constexpr ((PHMASK & 16) != 0)
        { PHASE_CTX(); unsigned char* ws = WSP(); bf16* HB = (bf16*)(ws + WS_HB); bf16* WIN_T = (bf16*)(ws + WS_WIN); bf16* PROJ = (bf16*)(ws + WS_PROJ);
          pg8::Gemm g{HB, WIN_T + (size_t)l * PCALL * DM, NT, PCM, DM}; pg8::StaticOrder S; S.init(NT, PCM, C.G, (int)blockIdx.x);
          pg8::EpiProj E{PROJ, PUV, 4, (pg8::bf16_t*)(ws + WS_QI), (pg8::bf16_t*)(ws + WS_KI)};
          pg8::gemm_phase<pg8::EpiProj, pg8::StaticOrder, true, true>(C.lds, g, S, E); }
        if constexpr ((PHMASK & 32) != 0)
        { PHASE_CTX(); unsigned char* ws = WSP(); bf16* HB = (bf16*)(ws + WS_HB); bf16* WIN_T = (bf16*)(ws + WS_WIN); bf16* VT = (bf16*)(ws + WS_VT);
          pg8::Gemm g{WIN_T + (size_t)l * PCALL * DM + (size_t)PCM * DM, HB, 512, NT, DM}; pg8::StaticOrder S; S.init(512, NT, C.G, (int)blockIdx.x);
          pg8::EpiVT E{VT};
          pg8::gemm_phase<pg8::EpiVT, pg8::StaticOrder, true, true>(C.lds, g, S, E); }
        }
        GRID_BAR();
        for (int rep = 0; rep < NREP(64); ++rep) {
        if constexpr ((PHMASK & 64) != 0)
        { PHASE_CTX(); unsigned char* ws = WSP(); const bf16* PROJ = (const bf16*)(ws + WS_PROJ); const bf16* SGUW = (const bf16*)(ws + WS_SGU); bf16* YMIX = (bf16*)(ws + WS_YMIX);
          const float* sgu_b = INP(8); const float* out_norm_a = INP(9);
          gmlp_phase(C, PROJ, SGUW + (size_t)l * 8 * 128 * 128, sgu_b + l * 8 * 128, out_norm_a + l * 512, YMIX);
        }
        __syncthreads(); }
        for (int rep = 0; rep < NREP(128); ++rep) {
        if constexpr ((PHMASK & 128) != 0)
        { PHASE_CTX(); unsigned char* ws = WSP(); const bf16* PROJ = (const bf16*)(ws + WS_PROJ); const bf16* VT = (const bf16*)(ws + WS_VT); bf16* YMIX = (bf16*)(ws + WS_YMIX);
          const float* out_norm_b = INP(10);
          for (int it = C.gw; it < BATCH * 8 * 64; it += C.NGW) { const int qb = 63 - (it & 63), hd = (it >> 6) & 7, b = it >> 9;
            attn_item((const bf16*)(ws + WS_QI), (const bf16*)(ws + WS_KI), VT, YMIX, out_norm_b + l * 512, b, hd, qb, C.lane); } }
        __syncthreads(); }
        GRID_BAR();
        for (int rep = 0; rep < NREP(256); ++rep)
        if constexpr ((PHMASK & 256) != 0)
        { PHASE_CTX(); unsigned char* ws = WSP(); const bf16* YMIX = (const bf16*)(ws + WS_YMIX); const bf16* WOUT_T = (const bf16*)(ws + WS_WOUT); bf16* XRES = (bf16*)(ws + WS_XRES);
          const float* modl = (const float*)(ws + WS_MOD) + (size_t)l * BATCH * MODW; const float* x = INP(0);
          pg8::Gemm g{YMIX, WOUT_T + (size_t)l * DM * DM, NT, DM, DM}; pg8::StaticOrder S; S.init(NT, DM, C.G, (int)blockIdx.x);
          pg8::EpiResid E{l == 0 ? x : (const float*)nullptr, (const pg8::bf16_t*)XRES, (rep + 1 < NREP(256)) ? (pg8::bf16_t*)(GAS float*)ld_ptr(PT, 18) : (pg8::bf16_t*)XRES, modl + 2 * DM, FOLD ? (float*)(ws + WS_SS) : (float*)nullptr};
          pg8::gemm_phase<pg8::EpiResid, pg8::StaticOrder, true, true>(C.lds, g, S, E); }
        GRID_BAR();
        for (int rep = 0; rep < NREP(1024); ++rep)
        if constexpr ((PHMASK & 1024) != 0)
        { PHASE_CTX(); unsigned char* ws = WSP(); const bf16* XRES = (const bf16*)(ws + WS_XRES); const bf16* WQS = (const bf16*)(ws + WS_WQS); bf16* QP = (bf16*)(ws + WS_PROJ);
          pg8::Gemm g{XRES, WQS + (size_t)l * BATCH * DM * DM, NT, DM, DM}; pg8::BatchOrder S; S.init(NT, DM, C.G, (int)blockIdx.x); S.bs = (size_t)DM * DM * 2;
          pg8::EpiQ E{QP, (const float*)(ws + WS_SS), (const float*)(ws + WS_CVEC) + (size_t)l * BATCH * DM};
          pg8::gemm_phase<pg8::EpiQ, pg8::BatchOrder, true, true>(C.lds, g, S, E); }
        GRID_BAR();
        for (int rep = 0; rep < NREP(4096); ++rep)
        if constexpr ((PHMASK & 4096) != 0)
        { PHASE_CTX(); unsigned char* ws = WSP(); ExpertArgs A; A.commit = (rep + 1 == NREP(4096));
          const float* mod = (const float*)(ws + WS_MOD);
          A.U8 = ws + WS_U8 + (size_t)l * NEXP * TROW; A.V8 = ws + WS_V8 + (size_t)l * NEXP * TROWV; A.SUA = (const float*)(ws + WS_YMIX + 32 * MiB);
          A.IDX = (const int*)(ws + WS_YMIX); A.GATE = (const float*)(ws + WS_YMIX + 16 * MiB); A.XRES = (res_t*)(ws + WS_XRES);
          A.gt2 = mod + (size_t)l * BATCH * MODW + 5 * DM; A.last = (l == 1); A.out = (float*)(GAS float*)ld_ptr(PT, 18); A.final_g = INP(17);
          A.gs2 = (const float*)(ws + WS_GS) + (size_t)l * BATCH * DM; A.sh2 = mod + (size_t)l * BATCH * MODW + 3 * DM;
          A.HB_out = (bf16*)(ws + WS_HB); A.g_next = INP(4) + DM; A.sh_next = mod + (size_t)BATCH * MODW; A.sc_next = mod + (size_t)BATCH * MODW + DM;
              {
                { const bf16* K1B = (const bf16*)(ws + WS_K12); const bf16* K2B = K1B + 2 * 128 * 64; const bf16* k1 = K1B + l * 128 * 64; const bf16* k2 = K2B + l * 128 * 64;
                  __syncthreads();
                  for (int i = C.tid; i < 2 * 128 * 8; i += NTHR) { const int tb = i >> 10, r = (i >> 3) & 127, c = i & 7;
                      *(LAS v4u*)(C.lds + tb * 18432 + r * 144 + c * 16) = *(const v4u*)((tb ? k2 : k1) + r * 64 + c * 8); }
                  __syncthreads(); }
                for (int blk = C.vcu; blk < NT / 32; blk += C.G) {
                    { unsigned char* wr_ = WSP();
                      route_item((const bf16*)(wr_ + WS_PROJ), C.lds, C.lds + 18432, (const float*)(wr_ + WS_SCL) + l * NEXP, (const float*)(wr_ + WS_SCL) + 2 * NEXP + l * NEXP,
                                 (int*)(wr_ + WS_YMIX), (float*)(wr_ + WS_YMIX + 16 * MiB), (float*)(wr_ + WS_YMIX + 32 * MiB), blk, C.wave, lane_now()); }
                    __syncthreads();
                    asm volatile("buffer_inv sc0" ::: "memory");
                    expert_rr4<0>(A, 32 * blk + 4 * C.wave, 1, lane_now()); } } }
        if (l == 0) GRID_BAR();
    }
}
}

extern "C" void kernel_launch(void* const* d_in, const int* in_sizes, int n_in, void* d_out, int out_size, void* d_ws, size_t ws_size, hipStream_t stream) {
    using namespace mk;
    static int grid = 0;
    if (grid == 0) {
        if (n_in != 18 || ws_size < WS_END) { fprintf(stderr, "kernel_launch: unexpected n_in %d or ws_size %zu (< %zu)\n", n_in, ws_size, (size_t)WS_END); grid = -1; return; }
        int dev = 0, cus = 0, per_cu = 0;
        if (hipGetDevice(&dev) != hipSuccess || hipDeviceGetAttribute(&cus, hipDeviceAttributeMultiprocessorCount, dev) != hipSuccess) { grid = -1; return; }
        if (hipFuncSetAttribute((const void*)mega_fwd, hipFuncAttributeMaxDynamicSharedMemorySize, LDS_BYTES) != hipSuccess) { fprintf(stderr, "kernel_launch: hipFuncSetAttribute failed\n"); grid = -1; return; }
        if (hipOccupancyMaxActiveBlocksPerMultiprocessor(&per_cu, (const void*)mega_fwd, NTHR, LDS_BYTES) != hipSuccess || per_cu < 1)
            fprintf(stderr, "kernel_launch: occupancy query reports %d workgroups per CU\n", per_cu);
        (void)hipGetLastError();
        grid = cus;
    }
    if (grid < 0) return;
    (void)hipMemsetAsync((char*)d_ws + WS_CTL, 0, CTL_ZERO_BYTES, stream);
    Args a{};
    for (int i = 0; i < 18; ++i) a.in[i] = (const float*)d_in[i];
    a.out = (float*)d_out; a.ws = (unsigned char*)d_ws; a.dbg = 0; a.pad = 0;
    hipLaunchKernelGGL(mega_fwd, dim3(grid), dim3(NTHR), LDS_BYTES, stream, a);
}
```

```cpp
#include <hip/hip_runtime.h>
#include <cstdio>
#include <cstdint>
namespace pg8 {
#define PG8_LAS __attribute__((address_space(3)))
typedef unsigned short bf16_t;
typedef short bf16x8 __attribute__((ext_vector_type(8)));
typedef float f32x4 __attribute__((ext_vector_type(4)));
typedef unsigned u32x4 __attribute__((ext_vector_type(4)));
constexpr int BM = 256, BK = 64, HALF = 128, HTB = HALF * BK * 2  , STAGE_BYTES = 8 * HTB, NXCD = 8, WGM = 8;

__host__ __device__ __forceinline__ int lds_byte(int r, int c) { const int st = (r >> 4) * 2 + (c >> 5), rr = r & 15, cc = c & 31, ob = rr * 64 + cc * 2; return st * 1024 + (ob ^ (((ob >> 9) & 1) << 5)); }
__host__ __device__ __forceinline__ void stage_rc(int b, int& R, int& C) { const int st = b / 1024, sb = b % 1024, swz = sb ^ (((sb >> 9) & 1) << 5); R = (st >> 1) * 16 + swz / 64; C = (st & 1) * 32 + (swz % 64) / 2; }
__host__ __device__ __forceinline__ int perm32(int rho) { const int n = rho >> 4, i = rho & 15; return 8 * (i >> 2) + 4 * n + (i & 3); }

struct Unit { int pm, pn; };
struct Gemm { const bf16_t* A; const bf16_t* Bt; int M, N, K; };

struct StaticOrder {
    int nM, nN, nwg, G, c;
    __host__ __device__ void init(int M, int N, int G_, int c_) { nM = M / BM; nN = N / BM; nwg = nM * nN; G = G_; c = c_; }
    __host__ __device__ bool next(int i, Unit& u) const {
        const long L = (long)i * G + c; if (L >= nwg) return false;
        int wgid = (int)L; { const int q = nwg / NXCD, r = nwg % NXCD, xcd = wgid % NXCD, off = wgid / NXCD; wgid = (xcd < r ? xcd * (q + 1) : r * (q + 1) + (xcd - r) * q) + off; }
        const int nig = WGM * nN, gid = wgid / nig, fm = gid * WGM, gsz = (nM - fm) < WGM ? (nM - fm) : WGM;
        u.pm = fm + ((wgid % nig) % gsz); u.pn = (wgid % nig) / gsz; return true;
    }
    __device__ __forceinline__ void a_ready(const Unit&) const {}
    __device__ __forceinline__ void done(const Unit&) const {}
    __device__ __forceinline__ size_t b_shift(const Unit&) const { return 0; }
};
struct BatchOrder : StaticOrder {
    size_t bs;
    __device__ __forceinline__ size_t b_shift(const Unit& u) const { return (size_t)(u.pm >> 3) * bs; }
};

__device__ __forceinline__ unsigned cvt_pk_bf16(float lo, float hi) { unsigned r; asm volatile("v_cvt_pk_bf16_f32 %0, %1, %2" : "=v"(r) : "v"(lo), "v"(hi)); return r; }
typedef float f32x2 __attribute__((ext_vector_type(2)));
__device__ __forceinline__ f32x2 gelu_pk(f32x2 v) {
    const f32x2 av = __builtin_elementwise_abs(v), d = av * 0.2316418882f + 1.0f;
    f32x2 t; t.x = __builtin_amdgcn_rcpf(d.x); t.y = __builtin_amdgcn_rcpf(d.y);
    f32x2 q = t * 0.5307027145f + (-0.7265760135f); q = q * t + 0.7107068705f; q = q * t + (-0.142248368f); q = q * t + 0.127414796f; q = q * t;
    const f32x2 s = (v * v) * (-0.72134752044f);
    f32x2 e; e.x = __builtin_amdgcn_exp2f(s.x); e.y = __builtin_amdgcn_exp2f(s.y);
    const f32x2 m = v * (q * e), r = v - m;
    f32x2 o; o.x = v.x < 0.f ? m.x : r.x; o.y = v.y < 0.f ? m.y : r.y; return o;
}

template <int ACT  > struct EpiBf16 {
    static constexpr bool PERM = true, AFTER_DRAIN = false; static_assert(ACT == 0 || ACT == 1, "EpiBf16: ACT is 0 (none) or 1 (gelu_pk)");
    bf16_t* O; int ldc; const float* bias; int split_cols; size_t split_stride; float scale0;
    __device__ __forceinline__ void operator()(const f32x4 (&acc)[2][2][4][2], const Unit& u, int wr, int wc, int fr, int fq) const {
        const int row0 = u.pm * BM + wr * 64 + fr; int colt = u.pn * BM; bf16_t* base = O;
        float sc = 1.f; if (split_cols) { const int t = colt / split_cols; base += (size_t)t * split_stride; colt -= t * split_cols; if (t == 0) sc = scale0; }
        const int col0 = colt + wc * 32 + 8 * fq, bcol0 = u.pn * BM + wc * 32 + 8 * fq;
        f32x4 bv[2][2];
#pragma unroll
        for (int bj = 0; bj < 2; ++bj)
#pragma unroll
            for (int n = 0; n < 2; ++n) bv[bj][n] = bias ? *(const f32x4*)(bias + bcol0 + bj * HALF + 4 * n) : (f32x4){0.f, 0.f, 0.f, 0.f};
#pragma unroll
        for (int ai = 0; ai < 2; ++ai)
#pragma unroll
            for (int m = 0; m < 4; ++m) { bf16_t* rowp = base + (size_t)(row0 + ai * HALF + m * 16) * ldc + col0;
#pragma unroll
                for (int bj = 0; bj < 2; ++bj) { f32x4 v0 = acc[ai][bj][m][0] + bv[bj][0], v1 = acc[ai][bj][m][1] + bv[bj][1];
                    if (ACT == 1) { f32x2 a = gelu_pk((f32x2){v0[0], v0[1]}), b = gelu_pk((f32x2){v0[2], v0[3]}), c = gelu_pk((f32x2){v1[0], v1[1]}), d = gelu_pk((f32x2){v1[2], v1[3]});
                        v0 = (f32x4){a.x, a.y, b.x, b.y}; v1 = (f32x4){c.x, c.y, d.x, d.y}; }
                    v0 = v0 * sc; v1 = v1 * sc; u32x4 w; w.x = cvt_pk_bf16(v0[0], v0[1]); w.y = cvt_pk_bf16(v0[2], v0[3]); w.z = cvt_pk_bf16(v1[0], v1[1]); w.w = cvt_pk_bf16(v1[2], v1[3]);
                    *(u32x4*)(rowp + bj * HALF) = w; } }
    }
};

template <class Epi, class Sched, bool ALIGN_EPI = false, bool SP2 = false>
__device__ __forceinline__ void gemm_phase(PG8_LAS unsigned char* lds, const Gemm g, const Sched& S, const Epi& E) {
    int tid_ = threadIdx.x; asm volatile("" : "+v"(tid_));
    const int tid = tid_, wid = __builtin_amdgcn_readfirstlane(tid >> 6), lane = tid & 63, wr = wid >> 2, wc = wid & 3, fr = lane & 15, fq = lane >> 4;
    const int K = g.K, nt = K / BK;
    unsigned voffA[2], voffB[2];
#pragma unroll
    for (int i = 0; i < 2; ++i) { int R, C; stage_rc(tid * 16 + i * 8192, R, C); const int Rb = Epi::PERM ? ((R & ~31) + perm32(R & 31)) : R;
        voffA[i] = (unsigned)(R * K + C) * 2u; voffB[i] = (unsigned)(Rb * K + C) * 2u; }
    const size_t kstep = (size_t)(BK * 2);
    const size_t hstep = (size_t)HALF * K * 2;
    const size_t tstep = 2 * hstep;
    const unsigned ldsw = (unsigned)wid * 1024u;
    const int aoff = lds_byte(wr * 64 + fr, fq * 8), boff = lds_byte(wc * 32 + fr, fq * 8);
#define PG8_SA(b, h) (((b) * 2 + (h)) * HTB)
#define PG8_SB(b, h) ((4 + (b) * 2 + (h)) * HTB)
#define PG8_STAGE(bufoff, gbase, voff) do { _Pragma("unroll") for (int _i = 0; _i < 2; ++_i) \
        __builtin_amdgcn_global_load_lds((const unsigned*)((const char*)(gbase) + (voff)[_i]), (PG8_LAS unsigned*)(lds + (bufoff) + ldsw + _i * 8192), 16, 0, 0); } while (0)
#define PG8_LDA(dst, b, h) do { _Pragma("unroll") for (int m = 0; m < 4; ++m) _Pragma("unroll") for (int k = 0; k < 2; ++k) dst[m][k] = *(const PG8_LAS bf16x8*)(lds + PG8_SA(b, h) + aoff + m * 2048 + k * 1024); } while (0)
#define PG8_LDB(dst, b, h) do { _Pragma("unroll") for (int n = 0; n < 2; ++n) _Pragma("unroll") for (int k = 0; k < 2; ++k) dst[n][k] = *(const PG8_LAS bf16x8*)(lds + PG8_SB(b, h) + boff + n * 2048 + k * 1024); } while (0)
#define PG8_MMA(ai, bj, At, Bt) do { __builtin_amdgcn_s_setprio(1); _Pragma("unroll") for (int m = 0; m < 4; ++m) _Pragma("unroll") for (int n = 0; n < 2; ++n) _Pragma("unroll") for (int k = 0; k < 2; ++k) \
        acc[ai][bj][m][n] = __builtin_amdgcn_mfma_f32_16x16x32_bf16(Bt[n][k], At[m][k], acc[ai][bj][m][n], 0, 0, 0); __builtin_amdgcn_s_setprio(0); } while (0)
#define PG8_WAIT_V(n) asm volatile("s_waitcnt vmcnt(" #n ")" ::: "memory")
#define PG8_WAIT_L(n) asm volatile("s_waitcnt lgkmcnt(" #n ")" ::: "memory")
#define PG8_BAR __builtin_amdgcn_s_barrier()
#define PG8_SCHED __builtin_amdgcn_sched_barrier(0)
    Unit cur, nxt; int ui = 0;
    if (!S.next(0, cur)) return;
    f32x4 acc[2][2][4][2];
#pragma unroll
    for (int a = 0; a < 2; ++a)
#pragma unroll
        for (int b = 0; b < 2; ++b)
#pragma unroll
            for (int m = 0; m < 4; ++m)
#pragma unroll
                for (int n = 0; n < 2; ++n) acc[a][b][m][n] = (f32x4){0.f, 0.f, 0.f, 0.f};
    bf16x8 At[4][2], B0[2][2], B1[2][2];
    const char* cA = (const char*)g.A + (size_t)cur.pm * tstep; const char* cB = (const char*)g.Bt + (size_t)cur.pn * tstep + S.b_shift(cur);
    S.a_ready(cur);
    if constexpr (SP2) {
        PG8_STAGE(PG8_SB(0, 0), cB, voffB); PG8_STAGE(PG8_SB(0, 1), cB + hstep, voffB); PG8_STAGE(PG8_SA(0, 0), cA, voffA); PG8_STAGE(PG8_SA(0, 1), cA + hstep, voffA);
        if (wr == 1) PG8_BAR;
        PG8_WAIT_V(2); PG8_BAR;
        PG8_STAGE(PG8_SB(1, 0), cB + kstep, voffB); PG8_STAGE(PG8_SA(1, 0), cA + kstep, voffA); PG8_STAGE(PG8_SB(1, 1), cB + hstep + kstep, voffB);
        PG8_WAIT_V(6); PG8_BAR;
    } else {
        PG8_STAGE(PG8_SB(0, 0), cB, voffB); PG8_STAGE(PG8_SA(0, 0), cA, voffA); PG8_STAGE(PG8_SB(0, 1), cB + hstep, voffB); PG8_STAGE(PG8_SA(0, 1), cA + hstep, voffA);
        if (wr == 1) PG8_BAR;
        PG8_WAIT_V(4); PG8_BAR;
        PG8_STAGE(PG8_SB(1, 0), cB + kstep, voffB); PG8_STAGE(PG8_SA(1, 0), cA + kstep, voffA); PG8_STAGE(PG8_SB(1, 1), cB + hstep + kstep, voffB);
        PG8_WAIT_V(6); PG8_BAR;
    }
    for (;;) {
        const bool has_next = S.next(ui + 1, nxt);
        const char* nA = has_next ? (const char*)g.A + (size_t)nxt.pm * tstep : cA; const char* nB = has_next ? (const char*)g.Bt + (size_t)nxt.pn * tstep + S.b_shift(nxt) : cB;
        for (int t = 0; t < nt; t += 2) {
            const bool last = (t == nt - 2);
            const char* a1 = cA + (size_t)(t + 1) * kstep;
            const char* a2 = last ? nA : cA + (size_t)(t + 2) * kstep; const char* b2 = last ? nB : cB + (size_t)(t + 2) * kstep;
            const char* a3 = a2 + kstep; const char* b3 = b2 + kstep;
            if (last && has_next) S.a_ready(nxt);
            if constexpr (SP2) {
            PG8_LDB(B0, 0, 0); PG8_LDB(B1, 0, 1); PG8_SCHED; PG8_LDA(At, 0, 0); PG8_STAGE(PG8_SA(1, 1), a1 + hstep, voffA);
            PG8_WAIT_V(8); PG8_WAIT_L(0); PG8_BAR; PG8_MMA(0, 0, At, B0); PG8_MMA(0, 1, At, B1); PG8_BAR; PG8_SCHED;
            PG8_LDA(At, 0, 1); PG8_STAGE(PG8_SB(0, 0), b2, voffB); PG8_STAGE(PG8_SB(0, 1), b2 + hstep, voffB); PG8_STAGE(PG8_SA(0, 0), a2, voffA);
            PG8_WAIT_V(8); PG8_WAIT_L(0); PG8_BAR; PG8_MMA(1, 0, At, B0); PG8_MMA(1, 1, At, B1); PG8_BAR; PG8_SCHED;
            PG8_LDB(B0, 1, 0); PG8_LDB(B1, 1, 1); PG8_SCHED; PG8_LDA(At, 1, 0); PG8_STAGE(PG8_SA(0, 1), a2 + hstep, voffA);
            PG8_WAIT_V(8); PG8_WAIT_L(0); PG8_BAR; PG8_MMA(0, 0, At, B0); PG8_MMA(0, 1, At, B1); PG8_BAR; PG8_SCHED;
            PG8_LDA(At, 1, 1); PG8_STAGE(PG8_SB(1, 0), b3, voffB); PG8_STAGE(PG8_SB(1, 1), b3 + hstep, voffB); PG8_STAGE(PG8_SA(1, 0), a3, voffA);
            PG8_WAIT_V(8); PG8_WAIT_L(0); PG8_BAR; PG8_MMA(1, 0, At, B0); PG8_MMA(1, 1, At, B1); PG8_BAR; PG8_SCHED;
            } else {
            PG8_LDB(B0, 0, 0); PG8_SCHED; PG8_LDA(At, 0, 0); PG8_STAGE(PG8_SA(1, 1), a1 + hstep, voffA);
            PG8_WAIT_L(8); PG8_BAR; PG8_WAIT_L(0); PG8_MMA(0, 0, At, B0); PG8_BAR; PG8_SCHED;
            PG8_LDB(B1, 0, 1); PG8_STAGE(PG8_SB(0, 0), b2, voffB);
            PG8_BAR; PG8_WAIT_L(0); PG8_MMA(0, 1, At, B1); PG8_BAR;
            PG8_LDA(At, 0, 1); PG8_STAGE(PG8_SA(0, 0), a2, voffA);
            PG8_BAR; PG8_WAIT_L(0); PG8_MMA(1, 0, At, B0); PG8_BAR; PG8_SCHED;
            PG8_STAGE(PG8_SB(0, 1), b2 + hstep, voffB);
            PG8_WAIT_V(6); PG8_BAR; PG8_MMA(1, 1, At, B1); PG8_BAR;
            PG8_LDB(B0, 1, 0); PG8_SCHED; PG8_LDA(At, 1, 0); PG8_STAGE(PG8_SA(0, 1), a2 + hstep, voffA);
            PG8_WAIT_L(8); PG8_BAR; PG8_WAIT_L(0); PG8_MMA(0, 0, At, B0); PG8_BAR; PG8_SCHED;
            PG8_LDB(B1, 1, 1); PG8_STAGE(PG8_SB(1, 0), b3, voffB);
            PG8_BAR; PG8_WAIT_L(0); PG8_MMA(0, 1, At, B1); PG8_BAR;
            PG8_LDA(At, 1, 1); PG8_STAGE(PG8_SA(1, 0), a3, voffA);
            PG8_BAR; PG8_WAIT_L(0); PG8_MMA(1, 0, At, B0); PG8_BAR; PG8_SCHED;
            PG8_STAGE(PG8_SB(1, 1), b3 + hstep, voffB);
            PG8_WAIT_V(6); PG8_BAR; PG8_MMA(1, 1, At, B1); PG8_BAR;
            }
        }
        if constexpr (ALIGN_EPI) { if (wr == 0) PG8_BAR; }
        if constexpr (!Epi::AFTER_DRAIN) { E(acc, cur, wr, wc, fr, fq); S.done(cur); }
        if (!has_next) break;
#pragma unroll
        for (int a = 0; a < 2; ++a)
#pragma unroll
            for (int b = 0; b < 2; ++b)
#pragma unroll
                for (int m = 0; m < 4; ++m)
#pragma unroll
                    for (int n = 0; n < 2; ++n) acc[a][b][m][n] = (f32x4){0.f, 0.f, 0.f, 0.f};
        cur = nxt; cA = nA; cB = nB; ++ui;
        if constexpr (ALIGN_EPI) { if (wr == 1) PG8_BAR; }
    }
    PG8_WAIT_V(0);
    if constexpr (!ALIGN_EPI) { if (wr == 0) PG8_BAR; }
    PG8_BAR;
    if constexpr (Epi::AFTER_DRAIN) { E.fused(acc, cur, wr, wc, fr, fq, lds, wid, lane); S.done(cur); }
#undef PG8_SA
#undef PG8_SB
#undef PG8_STAGE
#undef PG8_LDA
#undef PG8_LDB
#undef PG8_MMA
#undef PG8_WAIT_V
#undef PG8_WAIT_L
#undef PG8_BAR
#undef PG8_SCHED
}
}

#ifndef FOLD
#define FOLD 1
#endif
#ifndef RMERGE
#define RMERGE 1
#endif
#ifndef V4
#define V4 1
#endif
namespace pg8 {
__device__ __forceinline__ float lane_xchg(float v, int src_lane) { return __builtin_bit_cast(float, __builtin_amdgcn_ds_bpermute(src_lane << 2, __builtin_bit_cast(int, v))); }
__device__ __forceinline__ float gelu_tanh_f(float x) {
    const float u2 = 1.5957691216057308f * x * (1.f + 0.044715f * x * x);
    const float e = __builtin_amdgcn_exp2f(-u2 * 1.4426950408889634f);
    return x * __builtin_amdgcn_rcpf(1.f + e);
}
struct EpiProj {
    static constexpr bool PERM = true, AFTER_DRAIN = false;
    bf16_t* O; int ldc; int gelu_tiles; bf16_t* QI; bf16_t* KI;
    __device__ __forceinline__ void operator()(const f32x4 (&acc)[2][2][4][2], const Unit& u, int wr, int wc, int fr, int fq) const {
        const int row0 = u.pm * BM + wr * 64 + fr, col0 = u.pn * BM + wc * 32 + 8 * fq;
        const bool act = u.pn < gelu_tiles;
#pragma unroll
        for (int ai = 0; ai < 2; ++ai)
#pragma unroll
            for (int m = 0; m < 4; ++m) { const int row = row0 + ai * HALF + m * 16; bf16_t* rowp = O + (size_t)row * ldc + col0;
#pragma unroll
                for (int bj = 0; bj < 2; ++bj) { f32x4 v0 = acc[ai][bj][m][0], v1 = acc[ai][bj][m][1];
                    if (act) {
#pragma unroll
                        for (int e = 0; e < 4; ++e) { v0[e] = gelu_tanh_f(v0[e]); v1[e] = gelu_tanh_f(v1[e]); } }
                    u32x4 w; w.x = cvt_pk_bf16(v0[0], v0[1]); w.y = cvt_pk_bf16(v0[2], v0[3]); w.z = cvt_pk_bf16(v1[0], v1[1]); w.w = cvt_pk_bf16(v1[2], v1[3]);
                    if (u.pn < 4) *(u32x4*)(rowp + bj * HALF) = w;
                    else { const int c = col0 + bj * HALF - 1024; const int isk = c >> 9, hd = (c >> 6) & 7, dch = (c >> 3) & 7; const int pos = row & 31;
                        const int p2 = isk ? ((pos & ~12) | ((pos & 4) << 1) | ((pos & 8) >> 1)) : pos;
                        const size_t cell = ((((size_t)(row >> 5) * 8 + hd) * 4 + (dch >> 1)) * 2 + (dch & 1)) * 32 + p2;
                        *(u32x4*)((isk ? KI : QI) + cell * 8) = w; } } }
    }
};
struct EpiResid {
    static constexpr bool PERM = true, AFTER_DRAIN = false;
    const float* xin_f; const bf16_t* xin_h; bf16_t* xout; const float* gt; float* SS;
    __device__ __forceinline__ void operator()(const f32x4 (&acc)[2][2][4][2], const Unit& u, int wr, int wc, int fr, int fq) const {
        const int row0 = u.pm * BM + wr * 64 + fr, col0 = u.pn * BM + wc * 32 + 8 * fq;
        const int b = (u.pm * BM) >> 11;
        f32x4 g[2][2];
        float psq[2][4];
#pragma unroll
        for (int ai = 0; ai < 2; ++ai)
#pragma unroll
            for (int m = 0; m < 4; ++m) psq[ai][m] = 0.f;
#pragma unroll
        for (int bj = 0; bj < 2; ++bj)
#pragma unroll
            for (int n = 0; n < 2; ++n) g[bj][n] = *(const f32x4*)(gt + (size_t)b * 6144 + col0 + bj * HALF + 4 * n);
#pragma unroll
        for (int ai = 0; ai < 2; ++ai)
#pragma unroll
            for (int m = 0; m < 4; ++m) { const size_t ro = (size_t)(row0 + ai * HALF + m * 16) * 1024 + col0;
#pragma unroll
                for (int bj = 0; bj < 2; ++bj) { const size_t o = ro + bj * HALF; f32x4 x0, x1;
                    if (xin_f) { x0 = *(const f32x4*)(xin_f + o); x1 = *(const f32x4*)(xin_f + o + 4); }
                    else { const u32x4 w = *(const u32x4*)(xin_h + o);
                        x0 = (f32x4){__builtin_bit_cast(float, w.x << 16), __builtin_bit_cast(float, w.x & 0xffff0000u), __builtin_bit_cast(float, w.y << 16), __builtin_bit_cast(float, w.y & 0xffff0000u)};
                        x1 = (f32x4){__builtin_bit_cast(float, w.z << 16), __builtin_bit_cast(float, w.z & 0xffff0000u), __builtin_bit_cast(float, w.w << 16), __builtin_bit_cast(float, w.w & 0xffff0000u)}; }
                    const f32x4 v0 = x0 + g[bj][0] * acc[ai][bj][m][0], v1 = x1 + g[bj][1] * acc[ai][bj][m][1];
                    { const f32x4 q0 = v0 * v0, q1 = v1 * v1; psq[ai][m] += ((q0[0] + q0[1]) + (q0[2] + q0[3])) + ((q1[0] + q1[1]) + (q1[2] + q1[3])); }
                    u32x4 w; w.x = cvt_pk_bf16(v0[0], v0[1]); w.y = cvt_pk_bf16(v0[2], v0[3]); w.z = cvt_pk_bf16(v1[0], v1[1]); w.w = cvt_pk_bf16(v1[2], v1[3]);
                    *(u32x4*)(xout + o) = w; } }
        if (SS) { const int ln = fr + 16 * fq;
#pragma unroll
            for (int ai = 0; ai < 2; ++ai)
#pragma unroll
                for (int m = 0; m < 4; ++m) { float sq = psq[ai][m]; sq += lane_xchg(sq, ln ^ 16); sq += lane_xchg(sq, ln ^ 32);
                    if (fq == 0) SS[(size_t)(row0 + ai * HALF + m * 16) * 16 + u.pn * 4 + wc] = sq; } }
    }
};
struct EpiQ {
    static constexpr bool PERM = true, AFTER_DRAIN = false;
    bf16_t* O; const float* SS; const float* cvec;
    __device__ __forceinline__ void operator()(const f32x4 (&acc)[2][2][4][2], const Unit& u, int wr, int wc, int fr, int fq) const {
        const int row0 = u.pm * BM + wr * 64 + fr, col0 = u.pn * BM + wc * 32 + 8 * fq;
        const int b = (u.pm * BM) >> 11, ln = fr + 16 * fq;
        f32x4 cv[2][2];
#pragma unroll
        for (int bj = 0; bj < 2; ++bj)
#pragma unroll
            for (int n = 0; n < 2; ++n) cv[bj][n] = *(const f32x4*)(cvec + (size_t)b * 1024 + col0 + bj * HALF + 4 * n);
#pragma unroll
        for (int ai = 0; ai < 2; ++ai)
#pragma unroll
            for (int m = 0; m < 4; ++m) { const int row = row0 + ai * HALF + m * 16;
                const f32x4 pv = *(const f32x4*)(SS + (size_t)row * 16 + 4 * fq);
                float sq = (pv[0] + pv[1]) + (pv[2] + pv[3]); sq += lane_xchg(sq, ln ^ 16); sq += lane_xchg(sq, ln ^ 32);
                const float rs = __builtin_amdgcn_rsqf(sq * (1.f / 1024.f) + 1e-6f);
                bf16_t* rowp = O + (size_t)row * 1024 + col0;
#pragma unroll
                for (int bj = 0; bj < 2; ++bj) { const f32x4 v0 = acc[ai][bj][m][0] * rs + cv[bj][0], v1 = acc[ai][bj][m][1] * rs + cv[bj][1];
                    u32x4 w; w.x = cvt_pk_bf16(v0[0], v0[1]); w.y = cvt_pk_bf16(v0[2], v0[3]); w.z = cvt_pk_bf16(v1[0], v1[1]); w.w = cvt_pk_bf16(v1[2], v1[3]);
                    *(u32x4*)(rowp + bj * HALF) = w; } }
    }
};
struct EpiVT {
    static constexpr bool PERM = true, AFTER_DRAIN = false;
    bf16_t* O;
    __device__ __forceinline__ void operator()(const f32x4 (&acc)[2][2][4][2], const Unit& u, int wr, int wc, int fr, int fq) const {
        const int row0 = u.pm * BM + wr * 64 + fr, col0 = u.pn * BM + wc * 32 + 8 * fq;
#pragma unroll
        for (int ai = 0; ai < 2; ++ai)
#pragma unroll
            for (int m = 0; m < 4; ++m) { const int ch = row0 + ai * HALF + m * 16;
#pragma unroll
                for (int bj = 0; bj < 2; ++bj) { const f32x4 v0 = acc[ai][bj][m][0], v1 = acc[ai][bj][m][1];
                    u32x4 w; w.x = cvt_pk_bf16(v0[0], v0[1]); w.y = cvt_pk_bf16(v0[2], v0[3]); w.z = cvt_pk_bf16(v1[0], v1[1]); w.w = cvt_pk_bf16(v1[2], v1[3]);
                    const int tc = (col0 + bj * HALF) >> 3;
                    *(u32x4*)(O + ((size_t)tc * 512 + ch) * 8) = w; } }
    }
};
}

namespace mk {
#define GAS __attribute__((address_space(1)))
#define LAS __attribute__((address_space(3)))
typedef unsigned short bf16;
typedef unsigned v4u __attribute__((ext_vector_type(4)));
typedef unsigned v2u __attribute__((ext_vector_type(2)));
typedef int v4i __attribute__((ext_vector_type(4)));
typedef float f32x2 __attribute__((ext_vector_type(2)));
typedef float f32x4 __attribute__((ext_vector_type(4)));
typedef float f32x16 __attribute__((ext_vector_type(16)));
typedef short bf16x8 __attribute__((ext_vector_type(8)));
typedef short s16x4 __attribute__((ext_vector_type(4)));

constexpr int NWAVES = 8, NTHR = 512;
constexpr int BATCH = 16, SEQ = 2048, NT = BATCH * SEQ, DM = 1024, PCM = 2048, PCALL = 2560, MODW = 6144;
constexpr int PUV = 1024;
constexpr int NEXP = 16384;
constexpr int TROW = 1024;
constexpr int TROWV = TROW;
constexpr float EPSF = 1e-6f;
constexpr float STICK_T = 30.f;
constexpr size_t MiB = 1u << 20;
constexpr size_t WS_CTL = 0, CTL_ZERO_BYTES = 1 * MiB;
constexpr size_t WS_MOD = 1 * MiB;
constexpr size_t WS_WIN = 2 * MiB;
constexpr size_t WS_WOUT = 12 * MiB;
constexpr size_t WS_WQ = 16 * MiB;
constexpr size_t WS_SGU = 20 * MiB;
constexpr size_t WS_K12 = 20 * MiB + 512 * 1024;
constexpr size_t WS_SCL = 21 * MiB;
constexpr size_t WS_CHK = 21 * MiB + 512 * 1024;
constexpr size_t WS_U8 = 22 * MiB;
constexpr size_t WS_V8 = 54 * MiB;
constexpr size_t WS_XRES = 86 * MiB;
constexpr size_t WS_QI = 150 * MiB;
constexpr size_t WS_KI = 182 * MiB;
constexpr size_t WS_HB = 214 * MiB;
constexpr size_t WS_PROJ = 278 * MiB;
constexpr size_t WS_VT = 406 * MiB;
constexpr size_t WS_YMIX = 438 * MiB;
constexpr size_t WS_END = 511 * MiB;
constexpr size_t WS_WQS = 342 * MiB;
constexpr size_t WS_SS = WS_QI;
constexpr size_t WS_GS = 20 * MiB + 640 * 1024;
constexpr size_t WS_CVEC = 20 * MiB + 768 * 1024;
constexpr int CW_BAR = 4096;

constexpr int RING_BYTES = 131072, LDSCTL_OFF = 143360  , MISC_OFF = LDSCTL_OFF + 320, LDS_BYTES = 147456;

__device__ __forceinline__ unsigned f2bf(float f) { unsigned u = __builtin_bit_cast(unsigned, f); return (u + 0x7fffu + ((u >> 16) & 1u)) >> 16; }
__device__ __forceinline__ unsigned pk2(float lo, float hi) { return f2bf(lo) | (f2bf(hi) << 16); }
__device__ __forceinline__ float bf2f(unsigned short b) { return __builtin_bit_cast(float, (unsigned)b << 16); }
__device__ __forceinline__ float bflo(unsigned w) { return __builtin_bit_cast(float, w << 16); }
__device__ __forceinline__ float bfhi(unsigned w) { return __builtin_bit_cast(float, w & 0xffff0000u); }
#ifndef RES_BF16
#define RES_BF16 1
#endif
typedef bf16 res_t;
__device__ __forceinline__ f32x4 ld4(const float* row, int i) { return ((const f32x4*)row)[i]; }
__device__ __forceinline__ f32x4 ld4(const bf16* row, int i) { const v2u w = ((const v2u*)row)[i]; return (f32x4){bflo(w.x), bfhi(w.x), bflo(w.y), bfhi(w.y)}; }
__device__ __forceinline__ void st4(float* row, int i, f32x4 v) { ((f32x4*)row)[i] = v; }
__device__ __forceinline__ void st4(bf16* row, int i, f32x4 v) { v2u w; w.x = pk2(v.x, v.y); w.y = pk2(v.z, v.w); ((v2u*)row)[i] = w; }
__device__ __forceinline__ int lane_now() { int l = (int)__builtin_amdgcn_mbcnt_hi(~0u, __builtin_amdgcn_mbcnt_lo(~0u, 0u)); asm volatile("" : "+v"(l)); return l; }
__device__ __forceinline__ float shx(float v, int k) { return __builtin_bit_cast(float, __builtin_amdgcn_ds_bpermute((lane_now() ^ k) << 2, __builtin_bit_cast(int, v))); }
__device__ __forceinline__ int shi(int v, int src) { return __builtin_amdgcn_ds_bpermute(src << 2, v); }
__device__ __forceinline__ float shf(float v, int src) { return __builtin_bit_cast(float, __builtin_amdgcn_ds_bpermute(src << 2, __builtin_bit_cast(int, v))); }
template <int K> __device__ __forceinline__ int swz_xor(int v) { return __builtin_amdgcn_ds_swizzle(v, ((K & 31) << 10) | 0x1f); }
template <int K> __device__ __forceinline__ float swz_xorf(float v) { return __builtin_bit_cast(float, swz_xor<K>(__builtin_bit_cast(int, v))); }
__device__ __forceinline__ float wave_sum(float v) {
#pragma unroll
    for (int o = 1; o < 64; o <<= 1) v += shx(v, o);
    return v;
}
__device__ __forceinline__ float wave_max(float v) {
#pragma unroll
    for (int o = 1; o < 64; o <<= 1) v = fmaxf(v, shx(v, o));
    return v;
}
__device__ __forceinline__ float silu_f(float x) { return x / (1.f + __expf(-x)); }
__device__ __forceinline__ float softplus_fast(float z) {
    const float e = __builtin_amdgcn_exp2f(-fabsf(z) * 1.4426950408889634f);
    return fmaxf(z, 0.f) + __builtin_amdgcn_logf(1.f + e) * 0.6931471805599453f;
}
__device__ __forceinline__ float exp_fast(float x) { return __builtin_amdgcn_exp2f(x * 1.4426950408889634f); }

#define XB_TMO      128
#define XB_XCNT(j)  (256  + 64 * (j))
#define XB_XSUB(j)  (1280 + 64 * (j))
#define XB_XGEN(j)  (2304 + 64 * (j))
#define XB_TOP      3328
#define XB_TOPGEN   3392
#define XCD_BAR_WORDS 3456
#define XB_SPIN_CAP (1u << 18)

__device__ __forceinline__ unsigned xb_ld(unsigned* p)              { return __hip_atomic_load(p, __ATOMIC_RELAXED, __HIP_MEMORY_SCOPE_AGENT); }
__device__ __forceinline__ unsigned xb_add(unsigned* p, unsigned v) { return __hip_atomic_fetch_add(p, v, __ATOMIC_RELAXED, __HIP_MEMORY_SCOPE_AGENT); }
__device__ __forceinline__ unsigned xb_xcc_id() { return (unsigned)__builtin_amdgcn_s_getreg((3 << 11) | 20) & 0xFu; }
#define XB_SPIN(cond, bar) do { unsigned _sp = 0; while (cond) { __builtin_amdgcn_s_sleep(1); \
    if ((++_sp & 255u) == 0u) { if (xb_ld(&(bar)[XB_TMO])) break; if (_sp > XB_SPIN_CAP) { atomicAdd(&(bar)[XB_TMO], 1u); break; } } } } while (0)

struct XcdBarrier {
    unsigned* bar; unsigned x;
    volatile LAS unsigned* st;
};

__device__ __forceinline__ XcdBarrier xcd_barrier_post(unsigned* bar, volatile LAS unsigned* st) {
    XcdBarrier b; b.bar = bar; b.x = xb_xcc_id(); b.st = st;
    if (threadIdx.x == 0) (void)xb_add(&bar[XB_XCNT(b.x)], 1u);
    return b;
}
__device__ __forceinline__ void xcd_barrier_complete(unsigned* bar, unsigned x, unsigned& nloc, unsigned& nx) {
    const unsigned G = gridDim.x * gridDim.y * gridDim.z;
    unsigned sum, cnt, mine, sp = 0u;
    for (;;) {
        sum = 0u; cnt = 0u; mine = 0u;
#pragma unroll
        for (unsigned j = 0; j < 16; ++j) { const unsigned c = xb_ld(&bar[XB_XCNT(j)]); sum += c; cnt += (c > 0u) ? 1u : 0u; mine = (j == x) ? c : mine; }
        if (sum == G) break;
        __builtin_amdgcn_s_sleep(1);
        if ((++sp & 255u) == 0u) { if (xb_ld(&bar[XB_TMO])) break; if (sp > XB_SPIN_CAP) { atomicAdd(&bar[XB_TMO], 1u); break; } }
    }
    nloc = mine > 0u ? mine : 1u; nx = cnt > 0u ? cnt : 1u;
}

__device__ __forceinline__ void xcd_barrier(const XcdBarrier& b) {
    asm volatile("s_waitcnt vmcnt(0)" ::: "memory");
    __syncthreads();
    if (threadIdx.x == 0) {
        unsigned* bar = b.bar;
        __builtin_amdgcn_s_waitcnt(0);
        unsigned nloc = b.st[0], nx = b.st[1];
        if (nloc == 0u) { xcd_barrier_complete(bar, b.x, nloc, nx); b.st[0] = nloc; b.st[1] = nx; }
        const unsigned old = xb_add(&bar[XB_XSUB(b.x)], 1u);
        const unsigned gen = old / nloc;
        if (old + 1u == (gen + 1u) * nloc) {
            __builtin_amdgcn_fence(__ATOMIC_RELEASE, "agent");
            asm volatile("s_waitcnt vmcnt(0)" ::: "memory");
            const unsigned og = xb_add(&bar[XB_TOP], 1u);
            const unsigned tg = og / nx;
            if (og + 1u == (tg + 1u) * nx) xb_add(&bar[XB_TOPGEN], 1u);
            else XB_SPIN(xb_ld(&bar[XB_TOPGEN]) == tg, bar);
            __builtin_amdgcn_fence(__ATOMIC_ACQUIRE, "agent");
            xb_add(&bar[XB_XGEN(b.x)], 1u);
            asm volatile("s_waitcnt vmcnt(0)" ::: "memory");
        } else {
            XB_SPIN(xb_ld(&bar[XB_XGEN(b.x)]) == gen, bar);
            __builtin_amdgcn_fence(__ATOMIC_ACQUIRE, "agent");
            asm volatile("s_waitcnt vmcnt(0)" ::: "memory");
        }
    }
    __syncthreads();
}

struct Ctx {
    LAS unsigned char* lds;
    int tid, lane, wave, G, vcu, gw, NGW;
    unsigned char* ws;
};

__device__ __forceinline__ void p0_transpose_item(const float* W, int K, int N, bf16* WT, LAS float* scr, int item, int lane) {
    const int nblk = N / 32, kb = item / nblk, nb = item % nblk, k0 = 64 * kb, n0 = 32 * nb;
#pragma unroll 8
    for (int i = 0; i < 32; ++i) { const int kk = 2 * i + (lane >> 5); scr[kk * 33 + (lane & 31)] = W[(size_t)(k0 + kk) * N + n0 + (lane & 31)]; }
    asm volatile("s_waitcnt lgkmcnt(0)" ::: "memory");
    const int c = lane & 7;
#pragma unroll
    for (int j = 0; j < 4; ++j) { const int n = (lane >> 3) + 8 * j; const LAS float* s = scr + (8 * c) * 33 + n;
        v4u o; o.x = pk2(s[0 * 33], s[1 * 33]); o.y = pk2(s[2 * 33], s[3 * 33]); o.z = pk2(s[4 * 33], s[5 * 33]); o.w = pk2(s[6 * 33], s[7 * 33]);
        *(v4u*)(WT + (size_t)(n0 + n) * K + k0 + 8 * c) = o; }
    asm volatile("s_waitcnt lgkmcnt(0)" ::: "memory");
}

template <class TI> __device__ __forceinline__ void norm_row_bf16(const TI* xrow, const float* g, const float* sh, const float* sc, bf16* orow, int lane) {
    f32x4 v[4]; float ss = 0.f;
#pragma unroll
    for (int j = 0; j < 4; ++j) { v[j] = ld4(xrow, lane + 64 * j); ss += (v[j].x * v[j].x + v[j].y * v[j].y) + (v[j].z * v[j].z + v[j].w * v[j].w); }
    const float rs = rsqrtf(wave_sum(ss) * (1.f / DM) + EPSF);
#pragma unroll
    for (int j = 0; j < 4; ++j) {
        const f32x4 gg = ((const f32x4*)g)[lane + 64 * j], s1 = ((const f32x4*)sc)[lane + 64 * j], s0 = ((const f32x4*)sh)[lane + 64 * j];
        const f32x4 o = v[j] * rs * gg * (s1 + 1.f) + s0;
        v2u w; w.x = pk2(o.x, o.y); w.y = pk2(o.z, o.w);
        ((v2u*)orow)[lane + 64 * j] = w;
    }
}

template <class TI> __device__ __forceinline__ void norm_rows2_bf16(const TI* xa, const TI* xb, const float* g, const float* sha, const float* sca, const float* shb, const float* scb, bf16* oa, bf16* ob, int lane) {
    f32x4 va[4], vb[4]; float sa = 0.f, sb = 0.f;
#pragma unroll
    for (int j = 0; j < 4; ++j) { va[j] = ld4(xa, lane + 64 * j); vb[j] = ld4(xb, lane + 64 * j); }
#pragma unroll
    for (int j = 0; j < 4; ++j) { sa += (va[j].x * va[j].x + va[j].y * va[j].y) + (va[j].z * va[j].z + va[j].w * va[j].w); sb += (vb[j].x * vb[j].x + vb[j].y * vb[j].y) + (vb[j].z * vb[j].z + vb[j].w * vb[j].w); }
#pragma unroll
    for (int o = 1; o < 64; o <<= 1) { sa += shx(sa, o); sb += shx(sb, o); }
    const float ra = rsqrtf(sa * (1.f / DM) + EPSF), rb = rsqrtf(sb * (1.f / DM) + EPSF);
#pragma unroll
    for (int j = 0; j < 4; ++j) {
        const f32x4 gg = ((const f32x4*)g)[lane + 64 * j];
        { const f32x4 s1 = ((const f32x4*)sca)[lane + 64 * j], s0 = ((const f32x4*)sha)[lane + 64 * j]; const f32x4 o = va[j] * ra * gg * (s1 + 1.f) + s0; v2u w; w.x = pk2(o.x, o.y); w.y = pk2(o.z, o.w); ((v2u*)oa)[lane + 64 * j] = w; }
        { const f32x4 s1 = ((const f32x4*)scb)[lane + 64 * j], s0 = ((const f32x4*)shb)[lane + 64 * j]; const f32x4 o = vb[j] * rb * gg * (s1 + 1.f) + s0; v2u w; w.x = pk2(o.x, o.y); w.y = pk2(o.z, o.w); ((v2u*)ob)[lane + 64 * j] = w; }
    }
}

__device__ __forceinline__ void table_row_i8(const float* src, unsigned char* dst, float* inv_scale, int lane) {
    f32x4 v[4]; float mx = 0.f;
#pragma unroll
    for (int j = 0; j < 4; ++j) { v[j] = ((const f32x4*)src)[lane + 64 * j]; mx = fmaxf(mx, fmaxf(fmaxf(fabsf(v[j].x), fabsf(v[j].y)), fmaxf(fabsf(v[j].z), fabsf(v[j].w)))); }
    mx = wave_max(mx);
    const float scale = (mx > 1e-30f) ? 127.f / mx : 0.f, inv = (mx > 1e-30f) ? mx * (1.f / 127.f) : 0.f;
    v4u o;
#pragma unroll
    for (int j = 0; j < 4; ++j) {
        const int a = (int)rintf(v[j].x * scale), b = (int)rintf(v[j].y * scale), c = (int)rintf(v[j].z * scale), d = (int)rintf(v[j].w * scale);
        o[j] = ((unsigned)a & 255u) | (((unsigned)b & 255u) << 8) | (((unsigned)c & 255u) << 16) | (((unsigned)d & 255u) << 24); }
    ((v4u*)dst)[lane] = o;
    if (lane == 0) *inv_scale = inv;
}
__device__ __forceinline__ void table_row_i4(const float* src, unsigned char* dst, float* inv_scale, int lane) {
    f32x4 v[4]; float mx = 0.f;
#pragma unroll
    for (int j = 0; j < 4; ++j) { v[j] = ((const f32x4*)src)[lane + 64 * j]; mx = fmaxf(mx, fmaxf(fmaxf(fabsf(v[j].x), fabsf(v[j].y)), fmaxf(fabsf(v[j].z), fabsf(v[j].w)))); }
    mx = wave_max(mx);
    const float scale = (mx > 1e-30f) ? 7.f / mx : 0.f, inv = (mx > 1e-30f) ? mx * (1.f / 7.f) : 0.f;
    v2u o;
#pragma unroll
    for (int c = 0; c < 2; ++c) { unsigned w = 0;
#pragma unroll
        for (int i = 0; i < 4; ++i) { const int ql = (int)rintf(v[2 * c][i] * scale), qh = (int)rintf(v[2 * c + 1][i] * scale);
            w |= ((((unsigned)qh & 15u) << 4) | ((unsigned)(ql + 8) & 15u)) << (8 * i); }
        o[c] = w; }
    ((v2u*)dst)[lane] = o;
    if (lane == 0) *inv_scale = inv;
}

__device__ __forceinline__ bf16x8 pack8(const float* a) {
    v4u w; w.x = pk2(a[0], a[1]); w.y = pk2(a[2], a[3]); w.z = pk2(a[4], a[5]); w.w = pk2(a[6], a[7]);
    return __builtin_bit_cast(bf16x8, w);
}
__device__ __forceinline__ void attn_item(const bf16* QI, const bf16* KI, const bf16* VT, bf16* YMIX, const float* onb, int b, int hd, int qb, int lane) {
    const int n = lane & 31, h = lane >> 5;
    const size_t rowbase = (size_t)b * SEQ;
    const int t0 = qb * 32;
    bf16x8 qf[4];
    { const bf16* qp = QI + (((size_t)((rowbase + t0) >> 5) * 8 + hd) * 8 + h) * 256 + n * 8;
#pragma unroll
      for (int ks = 0; ks < 4; ++ks) qf[ks] = *(const bf16x8*)(qp + ks * 512); }
    const bf16* kbase = KI + (((size_t)(rowbase >> 5) * 8 + hd) * 8 + h) * 256 + n * 8;
    const bf16* vbase = VT + ((size_t)(rowbase >> 3) * 512 + hd * 64 + n) * 8 + (size_t)h * 512 * 8;
    f32x16 o0, o1;
#pragma unroll
    for (int i = 0; i < 16; ++i) { o0[i] = 0.f; o1[i] = 0.f; }
    float R = 0.f;
#define ATT_LOAD(kf_, va0_, va1_, j_) do { const bf16* kp_ = kbase + (size_t)(j_) * 16384; const bf16* vp_ = vbase + (size_t)(4 * (j_)) * 4096; \
        _Pragma("unroll") for (int ks = 0; ks < 4; ++ks) kf_[ks] = *(const bf16x8*)(kp_ + ks * 512); \
        _Pragma("unroll") for (int s_ = 0; s_ < 2; ++s_) { va0_[s_] = *(const bf16x8*)(vp_ + (size_t)(2 * s_) * 4096); va1_[s_] = *(const bf16x8*)(vp_ + (size_t)(2 * s_) * 4096 + 256); } } while (0)
#define ATT_BLOCK(kf_, va0_, va1_, j_) do { \
        f32x16 sacc; _Pragma("unroll") for (int i = 0; i < 16; ++i) sacc[i] = 0.f; \
        _Pragma("unroll") for (int ks = 0; ks < 4; ++ks) sacc = __builtin_amdgcn_mfma_f32_32x32x16_bf16(kf_[ks], qf[ks], sacc, 0, 0, 0); \
        const bool diag = ((j_) == qb); float sp[16], zz[16]; \
        _Pragma("unroll") for (int i = 0; i < 16; ++i) { const float z = sacc[i] * 0.125f; const int key = (i & 7) + 8 * h + 16 * (i >> 3); const bool valid = (!diag) || (key < n); \
            const float s_ = softplus_fast(z); sp[i] = valid ? s_ : 0.f; zz[i] = z; } \
        float g0_ = 0.f, g1_ = 0.f; _Pragma("unroll") for (int i = 0; i < 8; ++i) { g0_ += sp[i]; g1_ += sp[8 + i]; } \
        const float p0_ = shx(g0_, 32), p1_ = shx(g1_, 32); \
        float a[16]; \
        { float suf = (h == 0 ? p1_ : 0.f);                                     \
          _Pragma("unroll") for (int e = 7; e >= 0; --e) { const int i = 8 + e; const int key = e + 8 * h + 16; const bool valid = (!diag) || (key < n); \
              a[i] = valid ? exp_fast((zz[i] - sp[i]) + (R - suf)) : 0.f; suf += sp[i]; } } \
        { float suf = (h == 0 ? p0_ : 0.f) + g1_ + p1_;                         \
          _Pragma("unroll") for (int e = 7; e >= 0; --e) { const int i = e; const int key = e + 8 * h; const bool valid = (!diag) || (key < n); \
              a[i] = valid ? exp_fast((zz[i] - sp[i]) + (R - suf)) : 0.f; suf += sp[i]; } } \
        R -= (g0_ + p0_) + (g1_ + p1_); \
        const bf16x8 pf0 = pack8(a), pf1 = pack8(a + 8); \
        o0 = __builtin_amdgcn_mfma_f32_32x32x16_bf16(va0_[0], pf0, o0, 0, 0, 0); \
        o0 = __builtin_amdgcn_mfma_f32_32x32x16_bf16(va0_[1], pf1, o0, 0, 0, 0); \
        o1 = __builtin_amdgcn_mfma_f32_32x32x16_bf16(va1_[0], pf0, o1, 0, 0, 0); \
        o1 = __builtin_amdgcn_mfma_f32_32x32x16_bf16(va1_[1], pf1, o1, 0, 0, 0); } while (0)
    { bf16x8 kA[4], kB[4]; bf16x8 vA0[2], vA1[2], vB0[2], vB1[2];
      int j = qb;
      ATT_LOAD(kA, vA0, vA1, j);
      for (;;) {
          ATT_LOAD(kB, vB0, vB1, (j > 0 ? j - 1 : 0));
          ATT_BLOCK(kA, vA0, vA1, j);
          if (j == 0 || __all(R < -STICK_T)) break;
          --j;
          ATT_LOAD(kA, vA0, vA1, (j > 0 ? j - 1 : 0));
          ATT_BLOCK(kB, vB0, vB1, j);
          if (j == 0 || __all(R < -STICK_T)) break;
          --j;
      } }
#undef ATT_LOAD
#undef ATT_BLOCK
    float ss = 0.f;
#pragma unroll
    for (int i = 0; i < 16; ++i) ss += o0[i] * o0[i] + o1[i] * o1[i];
    ss += shx(ss, 32);
    const float rs = rsqrtf(ss * (1.f / 64.f) + EPSF);
    bf16* yp = YMIX + (rowbase + t0 + n) * DM + 512 + hd * 64 + 4 * h;
    const float* gp = onb + hd * 64 + 4 * h;
#pragma unroll
    for (int q = 0; q < 4; ++q) {
        const f32x4 g0 = *(const f32x4*)(gp + 8 * q), g1 = *(const f32x4*)(gp + 32 + 8 * q);
        v2u w0, w1;
        w0.x = pk2(o0[4 * q] * rs * g0.x, o0[4 * q + 1] * rs * g0.y); w0.y = pk2(o0[4 * q + 2] * rs * g0.z, o0[4 * q + 3] * rs * g0.w);
        w1.x = pk2(o1[4 * q] * rs * g1.x, o1[4 * q + 1] * rs * g1.y); w1.y = pk2(o1[4 * q + 2] * rs * g1.z, o1[4 * q + 3] * rs * g1.w);
        *(v2u*)(yp + 8 * q) = w0; *(v2u*)(yp + 32 + 8 * q) = w1;
    }
}

__device__ __forceinline__ void gmlp_unit(const Ctx& C, const bf16* PROJ, const bf16* SGUW_l, const float* bs_l, const float* ona_l, bf16* YMIX, int b, int c, int g,
                                          v4u r0, v4u r1, const bf16* next_vp, v4u& nr0, v4u& nr1) {
    const size_t R0 = (size_t)b * SEQ + c * 128;
    LAS unsigned short* vnT = (LAS unsigned short*)C.lds;
    LAS float* ssum = (LAS float*)(C.lds + 64 * 272);
    const int mb = C.wave & 1, tb = C.wave >> 1, n = C.lane & 31, h = C.lane >> 5;
    const int tt = C.tid >> 2, qd = C.tid & 3;
    const bf16* wp = SGUW_l + ((size_t)g * 128 + 32 * tb + n) * 128 + 8 * h;
    bf16x8 wf[8];
#pragma unroll
    for (int ks = 0; ks < 8; ++ks) wf[ks] = *(const bf16x8*)(wp + 16 * ks);
    const float bb = bs_l[g * 128 + 32 * tb + n];
    const bf16* up = PROJ + (R0 + 32 * tb + n) * PUV + g * 64 + 32 * mb + 4 * h;
    v2u uu[4];
#pragma unroll
    for (int q = 0; q < 4; ++q) uu[q] = *(const v2u*)(up + 8 * q);
    const float* op = ona_l + g * 64 + 32 * mb + 4 * h;
    f32x4 gg[4];
#pragma unroll
    for (int q = 0; q < 4; ++q) gg[q] = *(const f32x4*)(op + 8 * q);
    { float v[16];
#pragma unroll
      for (int e = 0; e < 4; ++e) { v[2 * e] = bflo(r0[e]); v[2 * e + 1] = bfhi(r0[e]); v[8 + 2 * e] = bflo(r1[e]); v[8 + 2 * e + 1] = bfhi(r1[e]); }
      nr0 = *(const v4u*)next_vp; nr1 = *(const v4u*)(next_vp + 8);
      float s = 0.f;
#pragma unroll
      for (int e = 0; e < 16; ++e) s += v[e];
      s += shx(s, 1); s += shx(s, 2);
      const float mu = s * (1.f / 64.f);
      float q = 0.f;
#pragma unroll
      for (int e = 0; e < 16; ++e) { const float d = v[e] - mu; q += d * d; }
      q += shx(q, 1); q += shx(q, 2);
      const float rstd = rsqrtf(q * (1.f / 64.f) + EPSF);
#pragma unroll
      for (int e = 0; e < 16; ++e) vnT[(16 * qd + e) * 136 + tt] = (unsigned short)f2bf((v[e] - mu) * rstd);
    }
    __syncthreads();
    f32x16 acc;
#pragma unroll
    for (int i = 0; i < 16; ++i) acc[i] = 0.f;
    const LAS unsigned char* ap = C.lds + (32 * mb + n) * 272 + 16 * h;
#pragma unroll
    for (int ks = 0; ks < 8; ++ks) {
        const bf16x8 af = *(const LAS bf16x8*)(ap + 32 * ks);
        acc = __builtin_amdgcn_mfma_f32_32x32x16_bf16(af, wf[ks], acc, 0, 0, 0);
    }
    float y[16]; float ss = 0.f;
#pragma unroll
    for (int q = 0; q < 4; ++q) {
        const float u0 = bflo(uu[q].x), u1 = bfhi(uu[q].x), u2 = bflo(uu[q].y), u3 = bfhi(uu[q].y);
        y[4 * q] = u0 * (acc[4 * q] + bb); y[4 * q + 1] = u1 * (acc[4 * q + 1] + bb); y[4 * q + 2] = u2 * (acc[4 * q + 2] + bb); y[4 * q + 3] = u3 * (acc[4 * q + 3] + bb);
#pragma unroll
        for (int e = 0; e < 4; ++e) ss += y[4 * q + e] * y[4 * q + e]; }
    ss += shx(ss, 32);
    if (h == 0) ssum[mb * 128 + 32 * tb + n] = ss;
    __syncthreads();
    const float tot = ssum[32 * tb + n] + ssum[128 + 32 * tb + n];
    const float rs = rsqrtf(tot * (1.f / 64.f) + EPSF);
    bf16* yp = YMIX + (R0 + 32 * tb + n) * DM + g * 64 + 32 * mb + 4 * h;
#pragma unroll
    for (int q = 0; q < 4; ++q) {
        v2u w; w.x = pk2(y[4 * q] * rs * gg[q].x, y[4 * q + 1] * rs * gg[q].y); w.y = pk2(y[4 * q + 2] * rs * gg[q].z, y[4 * q + 3] * rs * gg[q].w);
        *(v2u*)(yp + 8 * q) = w; }
}

__device__ __forceinline__ void gmlp_wave_unit(const bf16* PROJ, const bf16* SGUW_l, const float* bs_l, const float* ona_l, bf16* YMIX, int u, int lane, LAS unsigned char* lw) {
    const int g = u & 7, c = (u >> 3) & 15, b = u >> 7; const size_t R0 = (size_t)b * SEQ + c * 128;
    const int n = lane & 31, h = lane >> 5, tq = lane >> 2, qd = lane & 3, a32 = (lane ^ 32) << 2;
    v4u r0[8], r1[8];
#pragma unroll
    for (int r = 0; r < 8; ++r) { const bf16* vp = PROJ + (R0 + 16 * r + tq) * PUV + 512 + g * 64 + 16 * qd; r0[r] = *(const v4u*)vp; r1[r] = *(const v4u*)(vp + 8); }
    f32x4 gg[2][4];
#pragma unroll
    for (int mb = 0; mb < 2; ++mb)
#pragma unroll
        for (int q = 0; q < 4; ++q) gg[mb][q] = *(const f32x4*)(ona_l + g * 64 + 32 * mb + 4 * h + 8 * q);
    v2u uu[4][2][4]; float bbv[4];
#pragma unroll
    for (int tb = 0; tb < 4; ++tb) { const bf16* up = PROJ + (R0 + 32 * tb + n) * PUV + g * 64 + 4 * h; bbv[tb] = bs_l[g * 128 + 32 * tb + n];
#pragma unroll
        for (int mb = 0; mb < 2; ++mb)
#pragma unroll
            for (int q = 0; q < 4; ++q) uu[tb][mb][q] = *(const v2u*)(up + 32 * mb + 8 * q); }
    bf16x8 wfa[8], wfb[8];
    LAS unsigned short* vnT = (LAS unsigned short*)lw;
    float sm[8], sq[8];
#pragma unroll
    for (int r = 0; r < 8; ++r) { float a = 0.f;
#pragma unroll
        for (int e = 0; e < 4; ++e) a += (bflo(r0[r][e]) + bfhi(r0[r][e])) + (bflo(r1[r][e]) + bfhi(r1[r][e]));
        sm[r] = a; }
#pragma unroll
    for (int r = 0; r < 8; ++r) sm[r] += swz_xorf<1>(sm[r]);
#pragma unroll
    for (int r = 0; r < 8; ++r) sm[r] += swz_xorf<2>(sm[r]);
#pragma unroll
    for (int r = 0; r < 8; ++r) { const float mu = sm[r] * (1.f / 64.f); sm[r] = mu; float a = 0.f;
#pragma unroll
        for (int e = 0; e < 4; ++e) { const float d0 = bflo(r0[r][e]) - mu, d1 = bfhi(r0[r][e]) - mu, d2 = bflo(r1[r][e]) - mu, d3 = bfhi(r1[r][e]) - mu; a += (d0 * d0 + d1 * d1) + (d2 * d2 + d3 * d3); }
        sq[r] = a; }
#pragma unroll
    for (int r = 0; r < 8; ++r) sq[r] += swz_xorf<1>(sq[r]);
#pragma unroll
    for (int r = 0; r < 8; ++r) sq[r] += swz_xorf<2>(sq[r]);
#pragma unroll
    for (int r = 0; r < 8; ++r) { const float mu = sm[r], rstd = rsqrtf(sq[r] * (1.f / 64.f) + EPSF); const int tt = 16 * r + tq;
#pragma unroll
        for (int e = 0; e < 4; ++e) {
            vnT[(16 * qd + 2 * e) * 136 + tt] = (unsigned short)f2bf((bflo(r0[r][e]) - mu) * rstd); vnT[(16 * qd + 2 * e + 1) * 136 + tt] = (unsigned short)f2bf((bfhi(r0[r][e]) - mu) * rstd);
            vnT[(16 * qd + 8 + 2 * e) * 136 + tt] = (unsigned short)f2bf((bflo(r1[r][e]) - mu) * rstd); vnT[(16 * qd + 8 + 2 * e + 1) * 136 + tt] = (unsigned short)f2bf((bfhi(r1[r][e]) - mu) * rstd); } }
#define GW_LOADW(dst_, tb_) do { const bf16* wp_ = SGUW_l + ((size_t)g * 128 + 32 * (tb_) + n) * 128 + 8 * h; _Pragma("unroll") for (int ks = 0; ks < 2 * (tb_) + 2; ++ks) dst_[ks] = *(const bf16x8*)(wp_ + 16 * ks); } while (0)
#define GW_BLOCK(wf_, tb_) do { \
        f32x16 acc[2]; _Pragma("unroll") for (int i = 0; i < 16; ++i) { acc[0][i] = 0.f; acc[1][i] = 0.f; } \
        _Pragma("unroll") for (int ks = 0; ks < 2 * (tb_) + 2; ++ks) { \
            const bf16x8 af0 = *(const LAS bf16x8*)(lw + n * 272 + 16 * h + 32 * ks), af1 = *(const LAS bf16x8*)(lw + (32 + n) * 272 + 16 * h + 32 * ks); \
            acc[0] = __builtin_amdgcn_mfma_f32_32x32x16_bf16(af0, wf_[ks], acc[0], 0, 0, 0); \
            acc[1] = __builtin_amdgcn_mfma_f32_32x32x16_bf16(af1, wf_[ks], acc[1], 0, 0, 0); } \
        float y[2][16]; float ss = 0.f; const float bb = bbv[tb_]; \
        _Pragma("unroll") for (int mb = 0; mb < 2; ++mb) _Pragma("unroll") for (int q = 0; q < 4; ++q) { \
            const float u0 = bflo(uu[tb_][mb][q].x), u1 = bfhi(uu[tb_][mb][q].x), u2 = bflo(uu[tb_][mb][q].y), u3 = bfhi(uu[tb_][mb][q].y); \
            y[mb][4 * q] = u0 * (acc[mb][4 * q] + bb); y[mb][4 * q + 1] = u1 * (acc[mb][4 * q + 1] + bb); y[mb][4 * q + 2] = u2 * (acc[mb][4 * q + 2] + bb); y[mb][4 * q + 3] = u3 * (acc[mb][4 * q + 3] + bb); \
            _Pragma("unroll") for (int e = 0; e < 4; ++e) ss += y[mb][4 * q + e] * y[mb][4 * q + e]; } \
        ss += __builtin_bit_cast(float, __builtin_amdgcn_ds_bpermute(a32, __builtin_bit_cast(int, ss))); \
        const float rs = rsqrtf(ss * (1.f / 64.f) + EPSF); \
        bf16* yp = YMIX + (R0 + 32 * (tb_) + n) * DM + g * 64 + 4 * h; \
        _Pragma("unroll") for (int mb = 0; mb < 2; ++mb) _Pragma("unroll") for (int q = 0; q < 4; ++q) { \
            v2u w; w.x = pk2(y[mb][4 * q] * rs * gg[mb][q].x, y[mb][4 * q + 1] * rs * gg[mb][q].y); w.y = pk2(y[mb][4 * q + 2] * rs * gg[mb][q].z, y[mb][4 * q + 3] * rs * gg[mb][q].w); \
            *(v2u*)(yp + 32 * mb + 8 * q) = w; } \
        __builtin_amdgcn_sched_barrier(0); } while (0)
    GW_LOADW(wfa, 0); GW_LOADW(wfb, 1);
    GW_BLOCK(wfa, 0); GW_LOADW(wfa, 2); __builtin_amdgcn_sched_barrier(0);
    GW_BLOCK(wfb, 1); GW_LOADW(wfb, 3); __builtin_amdgcn_sched_barrier(0);
    GW_BLOCK(wfa, 2);
    GW_BLOCK(wfb, 3);
#undef GW_LOADW
#undef GW_BLOCK
}

__device__ __forceinline__ void gmlp_phase(const Ctx& C, const bf16* PROJ, const bf16* SGUW_l, const float* bs_l, const float* ona_l, bf16* YMIX) {
    constexpr int NU = BATCH * 16 * 8;
    if ((int)blockIdx.x >= NU) return;
    LAS unsigned short* vnT = (LAS unsigned short*)C.lds;
    LAS float* ssum = (LAS float*)(C.lds + 64 * 272);
    const int mb = C.wave & 1, tb = C.wave >> 1, n = C.lane & 31, h = C.lane >> 5;
    const int tt = C.tid >> 2, qd = C.tid & 3;
    auto vptr = [&](int u) { const int g = u & 7, c = (u >> 3) & 15, b = u >> 7; return PROJ + ((size_t)b * SEQ + c * 128 + tt) * PUV + 512 + g * 64 + 16 * qd; };
    auto uptr = [&](int u) { const int g = u & 7, c = (u >> 3) & 15, b = u >> 7; return PROJ + ((size_t)b * SEQ + c * 128 + 32 * tb + n) * PUV + g * 64 + 32 * mb + 4 * h; };
    int u = blockIdx.x, g_cur = u & 7;
    bf16x8 wf[8]; float bb; f32x4 gg[4];
#define GMLP_LOAD_G(g_) do { const bf16* wp_ = SGUW_l + ((size_t)(g_) * 128 + 32 * tb + n) * 128 + 8 * h; \
        _Pragma("unroll") for (int ks = 0; ks < 8; ++ks) wf[ks] = *(const bf16x8*)(wp_ + 16 * ks); \
        bb = bs_l[(g_) * 128 + 32 * tb + n]; const float* op_ = ona_l + (g_) * 64 + 32 * mb + 4 * h; \
        _Pragma("unroll") for (int q = 0; q < 4; ++q) gg[q] = *(const f32x4*)(op_ + 8 * q); } while (0)
    GMLP_LOAD_G(g_cur);
    v4u r0, r1; v2u uu[4];
    { const bf16* vp = vptr(u); r0 = *(const v4u*)vp; r1 = *(const v4u*)(vp + 8); const bf16* up = uptr(u);
#pragma unroll
      for (int q = 0; q < 4; ++q) uu[q] = *(const v2u*)(up + 8 * q); }
    for (; u < NU; u += C.G) {
        const int g = u & 7, c = (u >> 3) & 15, b = u >> 7;
        if (g != g_cur) { GMLP_LOAD_G(g); g_cur = g; }
        const size_t R0 = (size_t)b * SEQ + c * 128;
        const int un = (u + C.G < NU) ? u + C.G : u;
        v4u nr0, nr1; v2u nuu[4];
        { float v[16];
#pragma unroll
          for (int e = 0; e < 4; ++e) { v[2 * e] = bflo(r0[e]); v[2 * e + 1] = bfhi(r0[e]); v[8 + 2 * e] = bflo(r1[e]); v[8 + 2 * e + 1] = bfhi(r1[e]); }
          { const bf16* vp = vptr(un); nr0 = *(const v4u*)vp; nr1 = *(const v4u*)(vp + 8); const bf16* up = uptr(un);
#pragma unroll
            for (int q = 0; q < 4; ++q) nuu[q] = *(const v2u*)(up + 8 * q); }
          float s = 0.f;
#pragma unroll
          for (int e = 0; e < 16; ++e) s += v[e];
          s += shx(s, 1); s += shx(s, 2);
          const float mu = s * (1.f / 64.f);
          float q = 0.f;
#pragma unroll
          for (int e = 0; e < 16; ++e) { const float d = v[e] - mu; q += d * d; }
          q += shx(q, 1); q += shx(q, 2);
          const float rstd = rsqrtf(q * (1.f / 64.f) + EPSF);
#pragma unroll
          for (int e = 0; e < 16; ++e) vnT[(16 * qd + e) * 136 + tt] = (unsigned short)f2bf((v[e] - mu) * rstd);
        }
        __syncthreads();
        f32x16 acc;
#pragma unroll
        for (int i = 0; i < 16; ++i) acc[i] = 0.f;
        const LAS unsigned char* ap = C.lds + (32 * mb + n) * 272 + 16 * h;
#pragma unroll
        for (int ks = 0; ks < 8; ++ks) {
            const bf16x8 af = *(const LAS bf16x8*)(ap + 32 * ks);
            acc = __builtin_amdgcn_mfma_f32_32x32x16_bf16(af, wf[ks], acc, 0, 0, 0);
        }
        float y[16]; float ss = 0.f;
#pragma unroll
        for (int q = 0; q < 4; ++q) {
            const float u0 = bflo(uu[q].x), u1 = bfhi(uu[q].x), u2 = bflo(uu[q].y), u3 = bfhi(uu[q].y);
            y[4 * q] = u0 * (acc[4 * q] + bb); y[4 * q + 1] = u1 * (acc[4 * q + 1] + bb); y[4 * q + 2] = u2 * (acc[4 * q + 2] + bb); y[4 * q + 3] = u3 * (acc[4 * q + 3] + bb);
#pragma unroll
            for (int e = 0; e < 4; ++e) ss += y[4 * q + e] * y[4 * q + e]; }
        ss += shx(ss, 32);
        if (h == 0) ssum[mb * 128 + 32 * tb + n] = ss;
        __syncthreads();
        const float tot = ssum[32 * tb + n] + ssum[128 + 32 * tb + n];
        const float rs = rsqrtf(tot * (1.f / 64.f) + EPSF);
        bf16* yp = YMIX + (R0 + 32 * tb + n) * DM + g * 64 + 32 * mb + 4 * h;
#pragma unroll
        for (int q = 0; q < 4; ++q) {
            v2u w; w.x = pk2(y[4 * q] * rs * gg[q].x, y[4 * q + 1] * rs * gg[q].y); w.y = pk2(y[4 * q + 2] * rs * gg[q].z, y[4 * q + 3] * rs * gg[q].w);
            *(v2u*)(yp + 8 * q) = w; }
        r0 = nr0; r1 = nr1;
#pragma unroll
        for (int q = 0; q < 4; ++q) uu[q] = nuu[q];
    }
#undef GMLP_LOAD_G
}

__device__ __forceinline__ void ce_desc(float& a, float& b) { const float hi = fmaxf(a, b), lo = fminf(a, b); a = hi; b = lo; }
template <int K, int J> __device__ __forceinline__ void bstage(float (&v)[16]) {
#pragma unroll
    for (int i = 0; i < 16; ++i) { const int l = i ^ J; if (l > i) { if ((i & K) == 0) ce_desc(v[i], v[l]); else ce_desc(v[l], v[i]); } }
}
__device__ __forceinline__ void bitonic_merge_desc(float (&v)[16]) { bstage<16, 8>(v); bstage<16, 4>(v); bstage<16, 2>(v); bstage<16, 1>(v); }
__device__ __forceinline__ void sort16_desc(float (&v)[16]) {
    ce_desc(v[0], v[1]); ce_desc(v[2], v[3]); ce_desc(v[0], v[2]); ce_desc(v[1], v[3]); ce_desc(v[1], v[2]); ce_desc(v[4], v[5]); ce_desc(v[6], v[7]); ce_desc(v[4], v[6]); ce_desc(v[5], v[7]); ce_desc(v[5], v[6]); ce_desc(v[0], v[4]); ce_desc(v[2], v[6]); ce_desc(v[2], v[4]); ce_desc(v[1], v[5]); ce_desc(v[3], v[7]); ce_desc(v[3], v[5]); ce_desc(v[1], v[2]); ce_desc(v[3], v[4]); ce_desc(v[5], v[6]); ce_desc(v[8], v[9]); ce_desc(v[10], v[11]); ce_desc(v[8], v[10]); ce_desc(v[9], v[11]); ce_desc(v[9], v[10]); ce_desc(v[12], v[13]); ce_desc(v[14], v[15]); ce_desc(v[12], v[14]); ce_desc(v[13], v[15]); ce_desc(v[13], v[14]); ce_desc(v[8], v[12]); ce_desc(v[10], v[14]); ce_desc(v[10], v[12]); ce_desc(v[9], v[13]); ce_desc(v[11], v[15]); ce_desc(v[11], v[13]); ce_desc(v[9], v[10]); ce_desc(v[11], v[12]); ce_desc(v[13], v[14]); ce_desc(v[0], v[8]); ce_desc(v[4], v[12]); ce_desc(v[4], v[8]); ce_desc(v[2], v[10]); ce_desc(v[6], v[14]); ce_desc(v[6], v[10]); ce_desc(v[2], v[4]); ce_desc(v[6], v[8]); ce_desc(v[10], v[12]); ce_desc(v[1], v[9]); ce_desc(v[5], v[13]); ce_desc(v[5], v[9]); ce_desc(v[3], v[11]); ce_desc(v[7], v[15]); ce_desc(v[7], v[11]); ce_desc(v[3], v[5]); ce_desc(v[7], v[9]); ce_desc(v[11], v[13]); ce_desc(v[1], v[2]); ce_desc(v[3], v[4]); ce_desc(v[5], v[6]); ce_desc(v[7], v[8]); ce_desc(v[9], v[10]); ce_desc(v[11], v[12]); ce_desc(v[13], v[14]);
}
__device__ __forceinline__ void merge_top16(float (&L)[16], const float (&N)[16]) {
#pragma unroll
    for (int p = 0; p < 16; ++p) L[p] = fmaxf(L[p], N[15 - p]);
    bitonic_merge_desc(L);
}
__device__ __forceinline__ void insert_desc(float (&L)[16], float v) {
#pragma unroll
    for (int p = 0; p < 16; ++p) { const float hi = fmaxf(L[p], v); v = fminf(L[p], v); L[p] = hi; }
}
__device__ __forceinline__ float embed(float x, unsigned code, unsigned keep_mask) { return __builtin_bit_cast(float, (__builtin_bit_cast(unsigned, x) & keep_mask) | code); }

__device__ __forceinline__ void top16_scores(const bf16x8 (&qf)[4]  , const LAS unsigned char* kb  , int h, float (&L)[16]) {
#pragma unroll
    for (int mbk = 0; mbk < 4; ++mbk) {
        bf16x8 kf[4];
#pragma unroll
        for (int ks = 0; ks < 4; ++ks) kf[ks] = *(const LAS bf16x8*)(kb + mbk * 32 * 144 + 32 * ks);
        f32x16 acc;
#pragma unroll
        for (int i = 0; i < 16; ++i) acc[i] = 0.f;
#pragma unroll
        for (int ks = 0; ks < 4; ++ks) acc = __builtin_amdgcn_mfma_f32_32x32x16_bf16(kf[ks], qf[ks], acc, 0, 0, 0);
        float N[16];
#pragma unroll
        for (int i = 0; i < 16; ++i) N[i] = embed(acc[i], (unsigned)(32 * mbk + (i & 3) + 8 * (i >> 2)) | (unsigned)(4 * h), ~127u);
        sort16_desc(N);
        if (mbk == 0) {
#pragma unroll
            for (int i = 0; i < 16; ++i) L[i] = N[i];
        } else merge_top16(L, N);
    }
    float Pn[16]; const int a32_ = (lane_now() ^ 32) << 2;
#pragma unroll
    for (int i = 0; i < 16; ++i) Pn[i] = __builtin_bit_cast(float, __builtin_amdgcn_ds_bpermute(a32_, __builtin_bit_cast(int, L[i])));
    merge_top16(L, Pn);
}
__device__ __forceinline__ unsigned lookup7(const unsigned (&p)[4], unsigned a) {
    const unsigned w = a >> 2;
    const unsigned d = (w == 0u) ? p[0] : (w == 1u) ? p[1] : (w == 2u) ? p[2] : p[3];
    return (d >> (8u * (a & 3u))) & 127u;
}
__device__ __forceinline__ void route_item(const bf16* QP, const LAS unsigned char* K1L, const LAS unsigned char* K2L, const float* su_l, const float* sv_l, int* IDX, float* GATE, float* SUA, int tokblk, int hh, int lane) {
    const int n = lane & 31, h = lane >> 5;
    const int tok = tokblk * 32 + n;
    const bf16* qp = QP + (size_t)tok * DM + hh * 128 + 8 * h;
    float L1[16], L2[16];
    bf16x8 qf1[4], qf2[4];
#pragma unroll
    for (int ks = 0; ks < 4; ++ks) { qf1[ks] = *(const bf16x8*)(qp + 16 * ks); qf2[ks] = *(const bf16x8*)(qp + 64 + 16 * ks); }
    top16_scores(qf1, K1L + n * 144 + 16 * h, h, L1);
    top16_scores(qf2, K2L + n * 144 + 16 * h, h, L2);
    float Cc[16];
#pragma unroll
    for (int bq = 0; bq < 16; ++bq) Cc[bq] = embed(L1[0] + L2[bq], (unsigned)bq, ~255u);
    { float X[16];
#pragma unroll
      for (int i = 0; i < 8; ++i) X[7 - i] = embed(L1[1] + L2[i], 0x10u | (unsigned)i, ~255u);
#pragma unroll
      for (int i = 0; i < 8; ++i) X[8 + i] = embed(L1[8 + i] + L2[0], (unsigned)((8 + i) << 4), ~255u);
      bitonic_merge_desc(X);
      merge_top16(Cc, X); }
    { float Y[16];
      Y[0] = embed(L1[2] + L2[0], 0x20u, ~255u); Y[1] = embed(L1[2] + L2[1], 0x21u, ~255u); Y[2] = embed(L1[2] + L2[2], 0x22u, ~255u);
      Y[3] = embed(L1[2] + L2[3], 0x23u, ~255u); Y[4] = embed(L1[2] + L2[4], 0x24u, ~255u);
      Y[5] = embed(L1[3] + L2[0], 0x30u, ~255u); Y[6] = embed(L1[3] + L2[1], 0x31u, ~255u); Y[7] = embed(L1[3] + L2[2], 0x32u, ~255u); Y[8] = embed(L1[3] + L2[3], 0x33u, ~255u);
      Y[9] = embed(L1[4] + L2[0], 0x40u, ~255u); Y[10] = embed(L1[4] + L2[1], 0x41u, ~255u); Y[11] = embed(L1[4] + L2[2], 0x42u, ~255u);
      Y[12] = embed(L1[5] + L2[0], 0x50u, ~255u); Y[13] = embed(L1[5] + L2[1], 0x51u, ~255u);
      Y[14] = embed(L1[6] + L2[0], 0x60u, ~255u); Y[15] = embed(L1[6] + L2[1], 0x61u, ~255u);
      sort16_desc(Y);
      merge_top16(Cc, Y); }
    insert_desc(Cc, embed(L1[7] + L2[0], 0x70u, ~255u));
    insert_desc(Cc, embed(L1[7] + L2[1], 0x71u, ~255u));
    unsigned p1[4], p2[4];
#pragma unroll
    for (int w = 0; w < 4; ++w) {
        p1[w] = (__builtin_bit_cast(unsigned, L1[4 * w]) & 127u) | ((__builtin_bit_cast(unsigned, L1[4 * w + 1]) & 127u) << 8) | ((__builtin_bit_cast(unsigned, L1[4 * w + 2]) & 127u) << 16) | ((__builtin_bit_cast(unsigned, L1[4 * w + 3]) & 127u) << 24);
        p2[w] = (__builtin_bit_cast(unsigned, L2[4 * w]) & 127u) | ((__builtin_bit_cast(unsigned, L2[4 * w + 1]) & 127u) << 8) | ((__builtin_bit_cast(unsigned, L2[4 * w + 2]) & 127u) << 16) | ((__builtin_bit_cast(unsigned, L2[4 * w + 3]) & 127u) << 24);
    }
    const float m = Cc[0];
    float ex[16]; float sum = 0.f;
#pragma unroll
    for (int p = 0; p < 16; ++p) { ex[p] = exp_fast(Cc[p] - m); sum += ex[p]; }
    const float inv = 1.f / sum;
    const unsigned hmask = h ? 0xffffffffu : 0u;
    int ei[8]; float gv[8];
#pragma unroll
    for (int pp = 0; pp < 8; ++pp) {
        const unsigned cvb = (__builtin_bit_cast(unsigned, Cc[8 + pp]) & hmask) | (__builtin_bit_cast(unsigned, Cc[pp]) & ~hmask);
        const float ev = __builtin_bit_cast(float, (__builtin_bit_cast(unsigned, ex[8 + pp]) & hmask) | (__builtin_bit_cast(unsigned, ex[pp]) & ~hmask));
        const unsigned code = cvb & 255u;
        const unsigned i1 = lookup7(p1, code >> 4), i2 = lookup7(p2, code & 15u);
        ei[pp] = (int)(i1 * 128u + i2); gv[pp] = ev * inv;
    }
    float sq[8];
#pragma unroll
    for (int pp = 0; pp < 8; ++pp) { gv[pp] *= sv_l[ei[pp]]; sq[pp] = su_l[ei[pp]]; }
    int* ip = IDX + (size_t)tok * 128 + hh * 16 + 8 * h;
    float* gp = GATE + (size_t)tok * 128 + hh * 16 + 8 * h;
    float* sp = SUA + (size_t)tok * 128 + hh * 16 + 8 * h;
    *(v4i*)ip = (v4i){ei[0], ei[1], ei[2], ei[3]}; *(v4i*)(ip + 4) = (v4i){ei[4], ei[5], ei[6], ei[7]};
    *(f32x4*)gp = (f32x4){gv[0], gv[1], gv[2], gv[3]}; *(f32x4*)(gp + 4) = (f32x4){gv[4], gv[5], gv[6], gv[7]};
    *(f32x4*)sp = (f32x4){sq[0], sq[1], sq[2], sq[3]}; *(f32x4*)(sp + 4) = (f32x4){sq[4], sq[5], sq[6], sq[7]};
}

__device__ __forceinline__ float reduce16(float (&p)[16], int lane) {
    float r8[8], r4[4], r2[2];
    const bool b3 = (lane & 8) != 0, b2 = (lane & 4) != 0, b1 = (lane & 2) != 0, b0 = (lane & 1) != 0;
#pragma unroll
    for (int i = 0; i < 8; ++i) { const float keep = b3 ? p[i + 8] : p[i], send = b3 ? p[i] : p[i + 8]; r8[i] = keep + shx(send, 8); }
#pragma unroll
    for (int i = 0; i < 4; ++i) { const float keep = b2 ? r8[i + 4] : r8[i], send = b2 ? r8[i] : r8[i + 4]; r4[i] = keep + shx(send, 4); }
#pragma unroll
    for (int i = 0; i < 2; ++i) { const float keep = b1 ? r4[i + 2] : r4[i], send = b1 ? r4[i] : r4[i + 2]; r2[i] = keep + shx(send, 2); }
    float r = (b0 ? r2[1] : r2[0]) + shx(b0 ? r2[0] : r2[1], 1);
    r += shx(r, 16); r += shx(r, 32);
    return r;
}
__device__ __forceinline__ void sort128(unsigned& a0, unsigned& a1, int lane) {
#pragma unroll
    for (int k2 = 2; k2 <= 128; k2 <<= 1) {
#pragma unroll
        for (int j2 = k2 >> 1; j2 > 0; j2 >>= 1) {
            const bool asc = ((2 * lane) & k2) == 0;
            if (j2 == 1) {
                const unsigned lo = a0 < a1 ? a0 : a1, hi = a0 < a1 ? a1 : a0;
                a0 = asc ? lo : hi; a1 = asc ? hi : lo;
            } else {
                const int lm = j2 >> 1;
                const bool takemin = (((lane & lm) == 0) == asc);
                const unsigned o0 = (unsigned)__builtin_amdgcn_ds_bpermute((lane ^ lm) << 2, (int)a0), o1 = (unsigned)__builtin_amdgcn_ds_bpermute((lane ^ lm) << 2, (int)a1);
                const unsigned mn0 = a0 < o0 ? a0 : o0, mx0 = a0 < o0 ? o0 : a0, mn1 = a1 < o1 ? a1 : o1, mx1 = a1 < o1 ? o1 : a1;
                a0 = takemin ? mn0 : mx0; a1 = takemin ? mn1 : mx1;
            }
        }
    }
}
struct ExpertArgs { int commit; const unsigned char* U8; const unsigned char* V8; const float* SUA; const int* IDX; const float* GATE;
                    res_t* XRES; const float* gt2; int last; float* out; const float* final_g; bf16* HB_out; const float* g_next; const float* sh_next; const float* sc_next; const float* gs2; const float* sh2; };
__device__ __forceinline__ void load_h2(const ExpertArgs& A, int tok, int lane, f32x2 (&hv)[8]) {
    const int b = tok >> 11; f32x4 xv[4]; float ss = 0.f;
#pragma unroll
    for (int j = 0; j < 4; ++j) { xv[j] = ld4((const res_t*)(A.XRES + (size_t)tok * DM), lane + 64 * j); ss += (xv[j].x * xv[j].x + xv[j].y * xv[j].y) + (xv[j].z * xv[j].z + xv[j].w * xv[j].w); }
    const float rs = rsqrtf(wave_sum(ss) * (1.f / DM) + EPSF);
#pragma unroll
    for (int j = 0; j < 4; ++j) { const f32x4 gg = ((const f32x4*)(A.gs2 + (size_t)b * DM))[lane + 64 * j], s0 = ((const f32x4*)(A.sh2 + (size_t)b * MODW))[lane + 64 * j];
        const f32x4 o = xv[j] * rs * gg + s0; hv[2 * j] = (f32x2){o.x, o.y}; hv[2 * j + 1] = (f32x2){o.z, o.w}; }
}

__device__ __forceinline__ void token_epilogue(const ExpertArgs& A, int tok, const int (&yi)[16], float cqs, int lane) {
    const int b = tok >> 11;
    f32x4 x2[4]; float ss = 0.f;
#pragma unroll
    for (int j = 0; j < 4; ++j) {
        const f32x4 xv = ld4((const res_t*)(A.XRES + (size_t)tok * DM), lane + 64 * j);
        const f32x4 gg = ((const f32x4*)(A.gt2 + (size_t)b * MODW))[lane + 64 * j];
        const f32x4 yy = {(float)yi[4 * j] * cqs, (float)yi[4 * j + 1] * cqs, (float)yi[4 * j + 2] * cqs, (float)yi[4 * j + 3] * cqs};
        x2[j] = xv + gg * yy;
        ss += (x2[j].x * x2[j].x + x2[j].y * x2[j].y) + (x2[j].z * x2[j].z + x2[j].w * x2[j].w);
    }
    const float rs = rsqrtf(wave_sum(ss) * (1.f / DM) + EPSF);
    if (!A.commit) { asm volatile("" :: "v"(rs)); return; }
    if (A.last) {
#pragma unroll
        for (int j = 0; j < 4; ++j) { const f32x4 gg = ((const f32x4*)A.final_g)[lane + 64 * j]; ((f32x4*)(A.out + (size_t)tok * DM))[lane + 64 * j] = x2[j] * rs * gg; }
    } else {
#pragma unroll
        for (int j = 0; j < 4; ++j) {
            st4(A.XRES + (size_t)tok * DM, lane + 64 * j, x2[j]);
            const f32x4 gg = ((const f32x4*)A.g_next)[lane + 64 * j], s1 = ((const f32x4*)(A.sc_next + (size_t)b * MODW))[lane + 64 * j], s0 = ((const f32x4*)(A.sh_next + (size_t)b * MODW))[lane + 64 * j];
            const f32x4 o = x2[j] * rs * gg * (s1 + 1.f) + s0;
            v2u w; w.x = pk2(o.x, o.y); w.y = pk2(o.z, o.w);
            ((v2u*)(A.HB_out + (size_t)tok * DM))[lane + 64 * j] = w;
        }
    }
}

#define RR4_STEP(K_, OP_) do { float o_[4]; _Pragma("unroll") for (int t = 0; t < 4; ++t) o_[t] = swz_xorf<K_>(v[t]); _Pragma("unroll") for (int t = 0; t < 4; ++t) v[t] = OP_(v[t], o_[t]); } while (0)
#define RR4_LAST(OP_) do { float o_[4]; _Pragma("unroll") for (int t = 0; t < 4; ++t) o_[t] = __builtin_bit_cast(float, __builtin_amdgcn_ds_bpermute(a32, __builtin_bit_cast(int, v[t]))); _Pragma("unroll") for (int t = 0; t < 4; ++t) v[t] = OP_(v[t], o_[t]); } while (0)
__device__ __forceinline__ float add_f(float a, float b) { return a + b; }
__device__ __forceinline__ void wave_sum4(float (&v)[4], int a32) { RR4_STEP(1, add_f); RR4_STEP(2, add_f); RR4_STEP(4, add_f); RR4_STEP(8, add_f); RR4_STEP(16, add_f); RR4_LAST(add_f); }
__device__ __forceinline__ void wave_max4(float (&v)[4], int a32) { RR4_STEP(1, fmaxf); RR4_STEP(2, fmaxf); RR4_STEP(4, fmaxf); RR4_STEP(8, fmaxf); RR4_STEP(16, fmaxf); RR4_LAST(fmaxf); }
#undef RR4_STEP
#undef RR4_LAST
__device__ __forceinline__ void sort128x4(unsigned (&a0)[4], unsigned (&a1)[4], int lane) {
#pragma unroll
    for (int k2 = 2; k2 <= 128; k2 <<= 1) {
#pragma unroll
        for (int j2 = k2 >> 1; j2 > 0; j2 >>= 1) {
            const bool asc = ((2 * lane) & k2) == 0;
            if (j2 == 1) {
#pragma unroll
                for (int t = 0; t < 4; ++t) { const unsigned lo = a0[t] < a1[t] ? a0[t] : a1[t], hi = a0[t] < a1[t] ? a1[t] : a0[t]; a0[t] = asc ? lo : hi; a1[t] = asc ? hi : lo; }
            } else {
                const int lm = j2 >> 1, adr = (lane ^ lm) << 2;
                const bool takemin = (((lane & lm) == 0) == asc);
                unsigned o0[4], o1[4];
#pragma unroll
                for (int t = 0; t < 4; ++t) { o0[t] = (unsigned)__builtin_amdgcn_ds_bpermute(adr, (int)a0[t]); o1[t] = (unsigned)__builtin_amdgcn_ds_bpermute(adr, (int)a1[t]); }
#pragma unroll
                for (int t = 0; t < 4; ++t) { const unsigned mn0 = a0[t] < o0[t] ? a0[t] : o0[t], mx0 = a0[t] < o0[t] ? o0[t] : a0[t], mn1 = a1[t] < o1[t] ? a1[t] : o1[t], mx1 = a1[t] < o1[t] ? o1[t] : a1[t];
                    a0[t] = takemin ? mn0 : mx0; a1[t] = takemin ? mn1 : mx1; }
            }
        }
    }
}
__device__ __forceinline__ void token_epilogue4(const ExpertArgs& A, int tok0, const int (&yo)[4][16], const float (&cqs)[4], int lane, int a32) {
    const int b = tok0 >> 11;
    v2u xr[4][4]; f32x4 gg[4];
#pragma unroll
    for (int t = 0; t < 4; ++t)
#pragma unroll
        for (int j = 0; j < 4; ++j) xr[t][j] = ((const v2u*)(A.XRES + (size_t)(tok0 + t) * DM))[lane + 64 * j];
#pragma unroll
    for (int j = 0; j < 4; ++j) gg[j] = ((const f32x4*)(A.gt2 + (size_t)b * MODW))[lane + 64 * j];
    f32x4 x2[4][4]; float ss[4];
#pragma unroll
    for (int t = 0; t < 4; ++t) { ss[t] = 0.f;
#pragma unroll
        for (int j = 0; j < 4; ++j) {
            const f32x4 xv = {bflo(xr[t][j].x), bfhi(xr[t][j].x), bflo(xr[t][j].y), bfhi(xr[t][j].y)};
            const f32x4 yy = {(float)yo[t][4 * j] * cqs[t], (float)yo[t][4 * j + 1] * cqs[t], (float)yo[t][4 * j + 2] * cqs[t], (float)yo[t][4 * j + 3] * cqs[t]};
            x2[t][j] = xv + gg[j] * yy;
            ss[t] += (x2[t][j].x * x2[t][j].x + x2[t][j].y * x2[t][j].y) + (x2[t][j].z * x2[t][j].z + x2[t][j].w * x2[t][j].w); } }
    wave_sum4(ss, a32);
    if (!A.commit) { asm volatile("" :: "v"(ss[0]), "v"(ss[1]), "v"(ss[2]), "v"(ss[3])); return; }
    if (A.last) {
        f32x4 fg[4];
#pragma unroll
        for (int j = 0; j < 4; ++j) fg[j] = ((const f32x4*)A.final_g)[lane + 64 * j];
#pragma unroll
        for (int t = 0; t < 4; ++t) { const float rs = rsqrtf(ss[t] * (1.f / DM) + EPSF);
#pragma unroll
            for (int j = 0; j < 4; ++j) ((f32x4*)(A.out + (size_t)(tok0 + t) * DM))[lane + 64 * j] = x2[t][j] * rs * fg[j]; }
    } else {
        f32x4 gn[4], s1[4], s0[4];
#pragma unroll
        for (int j = 0; j < 4; ++j) { gn[j] = ((const f32x4*)A.g_next)[lane + 64 * j]; s1[j] = ((const f32x4*)(A.sc_next + (size_t)b * MODW))[lane + 64 * j] + 1.f; s0[j] = ((const f32x4*)(A.sh_next + (size_t)b * MODW))[lane + 64 * j]; }
#pragma unroll
        for (int t = 0; t < 4; ++t) { const float rs = rsqrtf(ss[t] * (1.f / DM) + EPSF);
#pragma unroll
            for (int j = 0; j < 4; ++j) {
                st4(A.XRES + (size_t)(tok0 + t) * DM, lane + 64 * j, x2[t][j]);
                const f32x4 o = x2[t][j] * rs * gn[j] * s1[j] + s0[j];
                v2u w; w.x = pk2(o.x, o.y); w.y = pk2(o.z, o.w);
                ((v2u*)(A.HB_out + (size_t)(tok0 + t) * DM))[lane + 64 * j] = w; } }
    }
}
__device__ __forceinline__ int reduce8_i(const int (&p)[8], int lane, int a32) {
    int r4[4], r2[2];
    const bool b2 = (lane & 4) != 0, b1 = (lane & 2) != 0, b0 = (lane & 1) != 0;
#pragma unroll
    for (int i = 0; i < 4; ++i) { const int keep = b2 ? p[i + 4] : p[i], send = b2 ? p[i] : p[i + 4]; r4[i] = keep + swz_xor<4>(send); }
#pragma unroll
    for (int i = 0; i < 2; ++i) { const int keep = b1 ? r4[i + 2] : r4[i], send = b1 ? r4[i] : r4[i + 2]; r2[i] = keep + swz_xor<2>(send); }
    int r = (b0 ? r2[1] : r2[0]) + swz_xor<1>(b0 ? r2[0] : r2[1]);
    r += swz_xor<8>(r); r += swz_xor<16>(r); r += __builtin_amdgcn_ds_bpermute(a32, r);
    return r;
}
__device__ __forceinline__ int dot4_first(unsigned a, int b) { int d; asm("v_dot4_i32_i8 %0, %1, %2, 0" : "=v"(d) : "v"(a), "v"(b)); return d; }
__device__ __forceinline__ __amdgpu_buffer_rsrc_t make_rsrc(const void* p, unsigned bytes) {
    return __builtin_amdgcn_make_buffer_rsrc((void*)p, (short)0, (int)bytes, 0x00020000); }
template <int SYNTH> __device__ __forceinline__ void expert_rr4(const ExpertArgs& A, int tok0, int tstride, int lane, const v2u (&xr)[4][4], const f32x4 (&gg)[4], const f32x4 (&s0)[4]) {
    asm volatile("" : "+v"(lane));
    const unsigned loff = (unsigned)lane << 4; const int a32 = (lane ^ 32) << 2, lg8 = lane >> 3;
    const __amdgpu_buffer_rsrc_t rsrcU = make_rsrc(A.U8, (unsigned)NEXP * 1024u), rsrcV = make_rsrc(A.V8, (unsigned)NEXP * (unsigned)TROWV);
    int S0[4], S1[4], hq[4][4], cpkf[4]; float G0[4], G1[4], Q0[4], Q1[4], c0[4], c1[4], hsc[4], cqs[4], csum[4]; int tk[4];
    {
      int idx0[4], idx1[4]; float gt0[4], gt1[4], su0[4], su1[4];
#pragma unroll
      for (int t = 0; t < 4; ++t) { const size_t tok = (size_t)(tok0 + t * tstride);
          idx0[t] = A.IDX[tok * 128 + lane]; idx1[t] = A.IDX[tok * 128 + 64 + lane];
          gt0[t] = A.GATE[tok * 128 + lane]; gt1[t] = A.GATE[tok * 128 + 64 + lane];
          su0[t] = A.SUA[tok * 128 + lane]; su1[t] = A.SUA[tok * 128 + 64 + lane]; }
      f32x4 xv[4][4]; float ss[4];
#pragma unroll
      for (int t = 0; t < 4; ++t) { ss[t] = 0.f;
#pragma unroll
          for (int j = 0; j < 4; ++j) { xv[t][j] = (f32x4){bflo(xr[t][j].x), bfhi(xr[t][j].x), bflo(xr[t][j].y), bfhi(xr[t][j].y)};
              ss[t] += (xv[t][j].x * xv[t][j].x + xv[t][j].y * xv[t][j].y) + (xv[t][j].z * xv[t][j].z + xv[t][j].w * xv[t][j].w); } }
      wave_sum4(ss, a32);
      float mx[4];
#pragma unroll
      for (int t = 0; t < 4; ++t) { const float rs = rsqrtf(ss[t] * (1.f / DM) + EPSF); mx[t] = 0.f;
#pragma unroll
          for (int j = 0; j < 4; ++j) { xv[t][j] = xv[t][j] * rs * gg[j] + s0[j];
              mx[t] = fmaxf(mx[t], fmaxf(fmaxf(fabsf(xv[t][j].x), fabsf(xv[t][j].y)), fmaxf(fabsf(xv[t][j].z), fabsf(xv[t][j].w)))); } }
      wave_max4(mx, a32);
      unsigned k0[4], k1[4];
#pragma unroll
      for (int t = 0; t < 4; ++t) {
          const float qs = (mx[t] > 1e-30f) ? 127.f / mx[t] : 0.f; hsc[t] = (mx[t] > 1e-30f) ? mx[t] * (1.f / 127.f) : 0.f;
#pragma unroll
          for (int j = 0; j < 4; ++j) { const int a = (int)rintf(xv[t][j].x * qs), bq = (int)rintf(xv[t][j].y * qs), c = (int)rintf(xv[t][j].z * qs), d = (int)rintf(xv[t][j].w * qs);
              hq[t][j] = (int)(((unsigned)a & 255u) | (((unsigned)bq & 255u) << 8) | (((unsigned)c & 255u) << 16) | (((unsigned)d & 255u) << 24)); }
          k0[t] = ((unsigned)idx0[t] << 7) | (unsigned)lane; k1[t] = ((unsigned)idx1[t] << 7) | (unsigned)(lane + 64); }
      sort128x4(k0, k1, lane);
#pragma unroll
      for (int t = 0; t < 4; ++t) {
          S0[t] = (int)((k0[t] >> 7) << 10); S1[t] = (int)((k1[t] >> 7) << 10);
          const int p0 = (int)(k0[t] & 63u), p1 = (int)(k1[t] & 63u); const bool h0 = (k0[t] & 64u) != 0, h1 = (k1[t] & 64u) != 0;
          const float ga = shf(gt0[t], p0), gb = shf(gt1[t], p0), gc = shf(gt0[t], p1), gd = shf(gt1[t], p1);
          const float qa = shf(su0[t], p0), qb = shf(su1[t], p0), qc = shf(su0[t], p1), qd = shf(su1[t], p1);
          G0[t] = h0 ? gb : ga; G1[t] = h1 ? gd : gc; Q0[t] = h0 ? qb : qa; Q1[t] = h1 ? qd : qc;
          c0[t] = 0.f; c1[t] = 0.f; cpkf[t] = 0; cqs[t] = 0.f; csum[t] = 0.f; tk[t] = 0; } }
    int yi[4][16];
#pragma unroll
    for (int t = 0; t < 4; ++t)
#pragma unroll
        for (int i = 0; i < 16; ++i) yi[t][i] = 0;
#define RR_ISSUE(slot0, t_, g_, tab_) do { const int lb_ = 4 * (g_); _Pragma("unroll") for (int j = 0; j < 8; ++j) { const int e_ = __builtin_amdgcn_readlane((j & 1) ? S1[t_] : S0[t_], lb_ + (j >> 1)); \
        if (SYNTH == 1) { v4u q_; q_[0] = (unsigned)(e_ * 0x01010101) ^ (unsigned)lane; q_[1] = (unsigned)e_ + (unsigned)lane; q_[2] = q_[0] * 3u; q_[3] = q_[1] * 5u; asm volatile("" : "+v"(q_)); ring[(slot0) + j] = q_; } \
        else ring[(slot0) + j] = __builtin_bit_cast(v4u, __builtin_amdgcn_raw_buffer_load_b128(rsrcU, (int)loff, e_, 0)); } __builtin_amdgcn_sched_barrier(0); } while (0)
#define RR_ISSUEV(slot0, t_, g_) do { const int lb_ = 4 * (g_); _Pragma("unroll") for (int j = 0; j < 8; ++j) { const int e_ = __builtin_amdgcn_readlane((j & 1) ? S1[t_] : S0[t_], lb_ + (j >> 1)); \
        if (SYNTH == 1) { v2u q_; q_[0] = (unsigned)(e_ * 0x01010101) ^ (unsigned)lane; q_[1] = (unsigned)e_ + (unsigned)lane; asm volatile("" : "+v"(q_)); ring[(slot0) + j][0] = q_.x; ring[(slot0) + j][1] = q_.y; } \
        else { const v2u w_ = __builtin_bit_cast(v2u, __builtin_amdgcn_raw_buffer_load_b64(rsrcV, (int)(loff >> 1), e_, 0)); ring[(slot0) + j][0] = w_.x; ring[(slot0) + j][1] = w_.y; } } } while (0)
#define RR_U(slot0, t_, g_) do { int p[8]; \
        _Pragma("unroll") for (int j = 7; j >= 0; --j) { int acc = dot4_first(ring[(slot0) + j][0], hq[t_][0]); _Pragma("unroll") for (int w = 1; w < 4; ++w) acc = __builtin_amdgcn_sdot4((int)ring[(slot0) + j][w], hq[t_][w], acc, false); p[j] = acc; }        \
        const int tt_ = reduce8_i(p, lane, a32); tk[t_] = (lg8 == ((g_) & 7)) ? tt_ : tk[t_]; __builtin_amdgcn_sched_barrier(0); } while (0)
#define RR_UW(t_, w_) do { const int src = (lane >> 1) + 32 * (w_); \
        const float gka = shf(G0[t_], src), gkb = shf(G1[t_], src), ska = shf(Q0[t_], src), skb = shf(Q1[t_], src); \
        const float gk = (lane & 1) ? gkb : gka, sk = (lane & 1) ? skb : ska; \
        const float val = pg8::gelu_tanh_f((float)tk[t_] * (sk * hsc[t_])) * gk; \
        const float v0_ = shf(val, 2 * (lane & 31)), v1_ = shf(val, 2 * (lane & 31) + 1); const bool mine = ((lane >> 5) == (w_)); \
        c0[t_] = mine ? v0_ : c0[t_]; c1[t_] = mine ? v1_ : c1[t_]; } while (0)
#define RR_MID(t_) do { const float cm_ = wave_max(fmaxf(fabsf(c0[t_]), fabsf(c1[t_]))); const float q_ = (cm_ > 1e-30f) ? 127.f / cm_ : 0.f; cqs[t_] = (cm_ > 1e-30f) ? cm_ * (1.f / 127.f) : 0.f; \
        const float qa_ = rintf(c0[t_] * q_), qb_ = rintf(c1[t_] * q_); if (V4) csum[t_] = wave_sum(qa_ + qb_); \
        const unsigned pk_ = ((unsigned)(int)qa_ & 255u) | (((unsigned)(int)qb_ & 255u) << 8); \
        const unsigned nb_ = (unsigned)__builtin_amdgcn_ds_bpermute(((lane + 1) & 63) << 2, (int)pk_); cpkf[t_] = (int)(pk_ | (nb_ << 16)); } while (0)
#define RR_V(slot0, t_, g_) do { const int lb_ = 4 * (g_); \
        _Pragma("unroll") for (int gq = 0; gq < 2; ++gq) { const int cpk = __builtin_amdgcn_readlane(cpkf[t_], lb_ + 2 * gq); \
            _Pragma("unroll") for (int c = 0; c < 2; ++c) { \
                const unsigned r0_ = ring[(slot0) + 4 * gq][c], r1_ = ring[(slot0) + 4 * gq + 1][c], r2_ = ring[(slot0) + 4 * gq + 2][c], r3_ = ring[(slot0) + 4 * gq + 3][c]; \
                const unsigned pa_ = __builtin_amdgcn_perm(r1_, r0_, 0x05010400u), pb_ = __builtin_amdgcn_perm(r1_, r0_, 0x07030602u); \
                const unsigned pc_ = __builtin_amdgcn_perm(r3_, r2_, 0x05010400u), pd_ = __builtin_amdgcn_perm(r3_, r2_, 0x07030602u); \
                const unsigned t0_ = __builtin_amdgcn_perm(pc_, pa_, 0x05040100u), t1_ = __builtin_amdgcn_perm(pc_, pa_, 0x07060302u), t2_ = __builtin_amdgcn_perm(pd_, pb_, 0x05040100u), t3_ = __builtin_amdgcn_perm(pd_, pb_, 0x07060302u); \
                yi[t_][4 * c + 0] = __builtin_amdgcn_sdot4((int)t0_, cpk, yi[t_][4 * c + 0], false); yi[t_][8 + 4 * c + 0] = __builtin_amdgcn_sdot4((int)(t0_ & 0x0f0f0f0fu), cpk, yi[t_][8 + 4 * c + 0], false); \
                yi[t_][4 * c + 1] = __builtin_amdgcn_sdot4((int)t1_, cpk, yi[t_][4 * c + 1], false); yi[t_][8 + 4 * c + 1] = __builtin_amdgcn_sdot4((int)(t1_ & 0x0f0f0f0fu), cpk, yi[t_][8 + 4 * c + 1], false); \
                yi[t_][4 * c + 2] = __builtin_amdgcn_sdot4((int)t2_, cpk, yi[t_][4 * c + 2], false); yi[t_][8 + 4 * c + 2] = __builtin_amdgcn_sdot4((int)(t2_ & 0x0f0f0f0fu), cpk, yi[t_][8 + 4 * c + 2], false); \
                yi[t_][4 * c + 3] = __builtin_amdgcn_sdot4((int)t3_, cpk, yi[t_][4 * c + 3], false); yi[t_][8 + 4 * c + 3] = __builtin_amdgcn_sdot4((int)(t3_ & 0x0f0f0f0fu), cpk, yi[t_][8 + 4 * c + 3], false); } \
            __builtin_amdgcn_sched_barrier(0); } } while (0)
    { v4u ring[24];
      RR_ISSUE(0, 0, 0, A.U8); RR_ISSUE(8, 1, 0, A.U8); RR_ISSUE(16, 2, 0, A.U8);
#pragma unroll 1
      for (int it = 0; it < 5; ++it) { const int gb = 3 * it;
          RR_U(0, 0, gb + 0); RR_ISSUE(0, 3, gb + 0, A.U8);
          RR_U(8, 1, gb + 0); RR_ISSUE(8, 0, gb + 1, A.U8);
          RR_U(16, 2, gb + 0); RR_ISSUE(16, 1, gb + 1, A.U8);
          RR_U(0, 3, gb + 0); RR_ISSUE(0, 2, gb + 1, A.U8);
          RR_U(8, 0, gb + 1); if (gb == 6) RR_UW(0, 0); RR_ISSUE(8, 3, gb + 1, A.U8);
          RR_U(16, 1, gb + 1); if (gb == 6) RR_UW(1, 0); RR_ISSUE(16, 0, gb + 2, A.U8);
          RR_U(0, 2, gb + 1); if (gb == 6) RR_UW(2, 0); RR_ISSUE(0, 1, gb + 2, A.U8);
          RR_U(8, 3, gb + 1); if (gb == 6) RR_UW(3, 0); RR_ISSUE(8, 2, gb + 2, A.U8);
          RR_U(16, 0, gb + 2); RR_ISSUE(16, 3, gb + 2, A.U8);
          RR_U(0, 1, gb + 2); RR_ISSUE(0, 0, gb + 3, A.U8);
          RR_U(8, 2, gb + 2); RR_ISSUE(8, 1, gb + 3, A.U8);
          RR_U(16, 3, gb + 2); RR_ISSUE(16, 2, gb + 3, A.U8);
          __builtin_amdgcn_s_barrier();
      }
      RR_U(0, 0, 15); RR_ISSUE(0, 3, 15, A.U8); RR_UW(0, 1);
      RR_U(8, 1, 15); RR_ISSUEV(8, 0, 0); RR_UW(1, 1);
      RR_U(16, 2, 15); RR_ISSUEV(16, 1, 0); RR_UW(2, 1);
      RR_U(0, 3, 15); RR_ISSUEV(0, 2, 0); RR_UW(3, 1);
      RR_MID(0); RR_MID(1); RR_MID(2); RR_MID(3);
#pragma unroll 1
      for (int it = 0; it < 5; ++it) { const int gb = 3 * it;
          RR_V(8, 0, gb + 0); RR_ISSUEV(8, 3, gb + 0);
          RR_V(16, 1, gb + 0); RR_ISSUEV(16, 0, gb + 1);
          RR_V(0, 2, gb + 0); RR_ISSUEV(0, 1, gb + 1);
          RR_V(8, 3, gb + 0); RR_ISSUEV(8, 2, gb + 1);
          RR_V(16, 0, gb + 1); RR_ISSUEV(16, 3, gb + 1);
          RR_V(0, 1, gb + 1); RR_ISSUEV(0, 0, gb + 2);
          RR_V(8, 2, gb + 1); RR_ISSUEV(8, 1, gb + 2);
          RR_V(16, 3, gb + 1); RR_ISSUEV(16, 2, gb + 2);
          RR_V(0, 0, gb + 2); RR_ISSUEV(0, 3, gb + 2);
          RR_V(8, 1, gb + 2); RR_ISSUEV(8, 0, gb + 3);
          RR_V(16, 2, gb + 2); RR_ISSUEV(16, 1, gb + 3);
          RR_V(0, 3, gb + 2); RR_ISSUEV(0, 2, gb + 3);
      }
      RR_V(8, 0, 15); RR_ISSUEV(8, 3, 15);
      RR_V(16, 1, 15);
      RR_V(0, 2, 15);
      RR_V(8, 3, 15);
    }
#undef RR_ISSUE
#undef RR_ISSUEV
#undef RR_U
#undef RR_UW
#undef RR_MID
#undef RR_V
    { unsigned pa_ = 0x07060504u, pb_ = 0x03020100u; asm volatile("" : "+v"(pa_), "+v"(pb_));
      if (__builtin_amdgcn_perm(pa_, pb_, 0x06020400u) != 0x06020400u) { cqs[0] = cqs[1] = cqs[2] = cqs[3] = __builtin_nanf(""); } }
    { int yo[4][16];
#pragma unroll
      for (int t = 0; t < 4; ++t) { const int cs8 = 8 * (int)csum[t];
#pragma unroll
          for (int c = 0; c < 2; ++c)
#pragma unroll
              for (int i = 0; i < 4; ++i) { const int raw = yi[t][4 * c + i], lo = yi[t][8 + 4 * c + i]; yo[t][4 * (2 * c) + i] = lo - cs8; yo[t][4 * (2 * c + 1) + i] = (raw - lo) >> 4; } }
      token_epilogue4(A, tok0, yo, cqs, lane, a32); }
}


struct Args { const float* in[18]; float* out; unsigned char* ws; int dbg; int pad; };

#define CAS __attribute__((address_space(4)))
__device__ __forceinline__ unsigned long long ld_ptr(int, int i) {
    const volatile CAS unsigned long long* p = (const volatile CAS unsigned long long*)__builtin_amdgcn_kernarg_segment_ptr();
    return p[i];
}
#define INP(i) ((const float*)(const GAS float*)ld_ptr(PT, (i)))
#define WSP() ((unsigned char*)(GAS unsigned char*)ld_ptr(PT, 19))
#define PHASE_CTX() do { int t_ = threadIdx.x; asm volatile("" : "+v"(t_)); C.tid = t_; C.lane = t_ & 63; C.wave = __builtin_amdgcn_readfirstlane(t_ >> 6); \
        int G_ = gridDim.x; asm volatile("" : "+s"(G_)); C.G = G_; const int bx_ = blockIdx.x; C.vcu = (G_ % 8 == 0) ? (bx_ % 8) * (G_ / 8) + bx_ / 8 : bx_; \
        C.gw = C.vcu * NWAVES + C.wave; C.NGW = G_ * NWAVES; C.lds = (LAS unsigned char*)lds_raw; } while (0)
#ifndef PHMASK
#define PHMASK 0xFFFF
#endif
#ifndef REPMASK
#define REPMASK 0
#endif
#define NREP(bit) (((REPMASK) & (bit)) ? 2 : 1)

__global__ void __launch_bounds__(NTHR, 2) mega_fwd(Args args) {
    extern __shared__ __attribute__((aligned(16))) unsigned char lds_raw[];
    Ctx C; C.ws = nullptr;
    PHASE_CTX();
    for (int u = C.tid; u < (LDS_BYTES - LDSCTL_OFF) / 4; u += NTHR) ((LAS unsigned*)(C.lds + LDSCTL_OFF))[u] = 0u;
    __syncthreads();
#define MISC ((volatile LAS unsigned*)((LAS unsigned char*)lds_raw + MISC_OFF))
#define PT 0
    (void)xcd_barrier_post((unsigned*)(WSP() + WS_CTL) + CW_BAR, MISC + 8);
#define GRID_BAR() do { XcdBarrier bar_; bar_.bar = (unsigned*)(WSP() + WS_CTL) + CW_BAR; bar_.x = xb_xcc_id(); bar_.st = MISC + 8; xcd_barrier(bar_); } while (0)


    for (int rep0 = 0; rep0 < NREP(1); ++rep0) {
    if constexpr ((PHMASK & 1) != 0) {
    PHASE_CTX();
    const float* cvec = INP(1); const float* ada_w = INP(2); const float* ada_b = INP(3); float* mod = (float*)(WSP() + WS_MOD);
    for (int it = blockIdx.x; it < 192; it += C.G) {
        const int l = it / 96, e0 = (it % 96) * 64;
        LAS float* cs = (LAS float*)C.lds;
        LAS float* red = (LAS float*)(C.lds + 65536);
        for (int i = C.tid; i < BATCH * DM; i += NTHR) cs[i] = silu_f(cvec[i]);
        __syncthreads();
        float acc[16];
#pragma unroll
        for (int bb = 0; bb < 16; ++bb) acc[bb] = 0.f;
        const float* wp = ada_w + ((size_t)l * DM + C.wave * 128) * MODW + e0 + C.lane;
        const LAS float* cp = cs + C.wave * 128;
#pragma unroll 1
        for (int d0 = 0; d0 < 128; d0 += 32) {
            float wv[32];
#pragma unroll
            for (int d = 0; d < 32; ++d) wv[d] = wp[(size_t)(d0 + d) * MODW];
#pragma unroll
            for (int d = 0; d < 32; ++d)
#pragma unroll
                for (int bb = 0; bb < 16; ++bb) acc[bb] += cp[bb * DM + d0 + d] * wv[d]; }
#pragma unroll
        for (int bb = 0; bb < 16; ++bb) red[(C.wave * 16 + bb) * 64 + C.lane] = acc[bb];
        __syncthreads();
        for (int o = C.tid; o < 1024; o += NTHR) { const int bb = o >> 6, ln = o & 63; float s = ada_b[l * MODW + e0 + ln];
#pragma unroll
            for (int w8 = 0; w8 < 8; ++w8) s += red[(w8 * 16 + bb) * 64 + ln];
            mod[((size_t)l * BATCH + bb) * MODW + e0 + ln] = s; }
        __syncthreads();
    } }
    if constexpr ((PHMASK & 2) != 0) {
        PHASE_CTX(); unsigned char* ws = WSP();
        const float* w_in = INP(6); const float* w_out = INP(11); const float* peer_wq = INP(12);
        bf16* WIN_T = (bf16*)(ws + WS_WIN); bf16* WOUT_T = (bf16*)(ws + WS_WOUT); bf16* WQ_T = (bf16*)(ws + WS_WQ);
        LAS float* scr = (LAS float*)(C.lds + C.wave * 16384);
        for (int it = C.gw; it < 4608; it += C.NGW) {
            const int l = it / 2304; int r = it % 2304;
            if (r < 1280) { p0_transpose_item(w_in + (size_t)l * DM * PCALL, DM, PCALL, WIN_T + (size_t)l * PCALL * DM, scr, r, C.lane); continue; } r -= 1280;
            if (r < 512) { p0_transpose_item(w_out + (size_t)l * DM * DM, DM, DM, WOUT_T + (size_t)l * DM * DM, scr, r, C.lane); continue; } r -= 512;
            p0_transpose_item(peer_wq + (size_t)l * DM * DM, DM, DM, WQ_T + (size_t)l * DM * DM, scr, r, C.lane);
        }
        const float* sgu_w = INP(7); const float* peer_k1 = INP(13); const float* peer_k2 = INP(14);
        bf16* SGUW = (bf16*)(ws + WS_SGU); bf16* K1B = (bf16*)(ws + WS_K12); bf16* K2B = K1B + 2 * 128 * 64;
        const int gt = C.gw * 64 + C.lane, NGT = C.NGW * 64;
        for (int i = gt; i < 2 * 8 * 128 * 128; i += NGT) { const int s = i & 127, t = (i >> 7) & 127; SGUW[i] = (bf16)f2bf(s <= t ? sgu_w[i] : 0.f); }
        for (int i = gt; i < 2 * 128 * 64; i += NGT) { K1B[i] = (bf16)f2bf(peer_k1[i]); K2B[i] = (bf16)f2bf(peer_k2[i]); }
    }
    if constexpr ((PHMASK & 8) != 0) {
        PHASE_CTX(); unsigned char* ws = WSP(); const float* peer_u = INP(15); const float* peer_v = INP(16);
        float* SCLU = (float*)(ws + WS_SCL); float* SCLV = SCLU + 2 * NEXP; unsigned char* U8 = ws + WS_U8; unsigned char* V8 = ws + WS_V8;
        for (int r = C.gw; r < 4 * NEXP; r += C.NGW) { const int tab = r >> 15, rr = r & 32767;
            if (tab) table_row_i4(peer_v + (size_t)rr * DM, V8 + (size_t)rr * TROWV, SCLV + rr, C.lane);
            else table_row_i8(peer_u + (size_t)rr * DM, U8 + (size_t)rr * TROW, SCLU + rr, C.lane);
        } }
    __syncthreads(); }
    GRID_BAR();
    for (int rep0 = 0; rep0 < NREP(4); ++rep0) {
    if constexpr ((PHMASK & 4) != 0) {
        PHASE_CTX(); unsigned char* ws = WSP(); const float* x = INP(0); const float* norm1_g = INP(4); const float* mod = (const float*)(ws + WS_MOD); bf16* HB = (bf16*)(ws + WS_HB);
        for (int m = 2 * C.gw; m < NT; m += 2 * C.NGW) { const int m2 = m + 1; const int b = m >> 11, b2 = (m2 < NT ? m2 : m) >> 11;
            if (m2 < NT) norm_rows2_bf16(x + (size_t)m * DM, x + (size_t)m2 * DM, norm1_g, mod + (size_t)b * MODW, mod + (size_t)b * MODW + DM, mod + (size_t)b2 * MODW, mod + (size_t)b2 * MODW + DM, HB + (size_t)m * DM, HB + (size_t)m2 * DM, C.lane);
            else norm_row_bf16(x + (size_t)m * DM, norm1_g, mod + (size_t)b * MODW, mod + (size_t)b * MODW + DM, HB + (size_t)m * DM, C.lane); } }
    if constexpr ((PHMASK & 4) != 0) {
        PHASE_CTX(); unsigned char* ws = WSP(); const float* norm2_g = INP(5); const float* mod = (const float*)(ws + WS_MOD);
        const bf16* WQ_T = (const bf16*)(ws + WS_WQ); bf16* WQS = (bf16*)(ws + WS_WQS); float* GS = (float*)(ws + WS_GS); float* CV = (float*)(ws + WS_CVEC);
        for (int it = C.gw; it < 2 * DM; it += C.NGW) { const int l = it >> 10, n = it & 1023;
            f32x4 w[4];
#pragma unroll
            for (int j = 0; j < 4; ++j) w[j] = ld4(WQ_T + ((size_t)l * DM + n) * DM, C.lane + 64 * j) * ((const f32x4*)(norm2_g + l * DM))[C.lane + 64 * j];
#pragma unroll 4
            for (int b = 0; b < BATCH; ++b) { const float* sc = mod + ((size_t)l * BATCH + b) * MODW + 4 * DM; bf16* o = WQS + (((size_t)l * BATCH + b) * DM + n) * DM;
#pragma unroll
                for (int j = 0; j < 4; ++j) st4(o, C.lane + 64 * j, w[j] * (((const f32x4*)sc)[C.lane + 64 * j] + 1.f)); } }
        for (int it = C.gw; it < 2 * BATCH; it += C.NGW) { const int l = it >> 4, b = it & 15; const float* sc = mod + ((size_t)l * BATCH + b) * MODW + 4 * DM;
#pragma unroll
            for (int j = 0; j < 4; ++j) ((f32x4*)(GS + (size_t)it * DM))[C.lane + 64 * j] = ((const f32x4*)(norm2_g + l * DM))[C.lane + 64 * j] * (((const f32x4*)sc)[C.lane + 64 * j] + 1.f); }
        for (int it = C.gw; it < 2 * BATCH * 64; it += C.NGW) { const int l = it >> 10, b = (it >> 6) & 15, n0 = (it & 63) * 16; const float* sh = mod + ((size_t)l * BATCH + b) * MODW + 3 * DM;
            f32x4 s4[4]; float pr[16];
#pragma unroll
            for (int j = 0; j < 4; ++j) s4[j] = ((const f32x4*)sh)[C.lane + 64 * j];
#pragma unroll
            for (int nn = 0; nn < 16; ++nn) { float a = 0.f;
#pragma unroll
                for (int j = 0; j < 4; ++j) { const f32x4 wv = ld4(WQ_T + ((size_t)l * DM + n0 + nn) * DM, C.lane + 64 * j); a += (wv.x * s4[j].x + wv.y * s4[j].y) + (wv.z * s4[j].z + wv.w * s4[j].w); }
                pr[nn] = a; }
            const float r = reduce16(pr, C.lane);
            if (C.lane < 16) CV[((size_t)l * BATCH + b) * DM + n0 + C.lane] = r; } }
    __syncthreads(); }
    GRID_BAR();

#pragma unroll
    for (int l = 0; l < 2; ++l) {
        for (int rep = 0; rep < NREP(16); ++rep) {
        if constexpr ((PHMASK & 16) != 0)
        { PHASE_CTX(); unsigned char* ws = WSP(); bf16* HB = (bf16*)(ws + WS_HB); bf16* WIN_T = (bf16*)(ws + WS_WIN); bf16* PROJ = (bf16*)(ws + WS_PROJ);
          pg8::Gemm g{HB, WIN_T + (size_t)l * PCALL * DM, NT, PCM, DM}; pg8::StaticOrder S; S.init(NT, PCM, C.G, (int)blockIdx.x);
          pg8::EpiProj E{PROJ, PUV, 4, (pg8::bf16_t*)(ws + WS_QI), (pg8::bf16_t*)(ws + WS_KI)};
          pg8::gemm_phase<pg8::EpiProj, pg8::StaticOrder, true, true>(C.lds, g, S, E); }
        if constexpr ((PHMASK & 32) != 0)
        { PHASE_CTX(); unsigned char* ws = WSP(); bf16* HB = (bf16*)(ws + WS_HB); bf16* WIN_T = (bf16*)(ws + WS_WIN); bf16* VT = (bf16*)(ws + WS_VT);
          pg8::Gemm g{WIN_T + (size_t)l * PCALL * DM + (size_t)PCM * DM, HB, 512, NT, DM}; pg8::StaticOrder S; S.init(512, NT, C.G, (int)blockIdx.x);
          pg8::EpiVT E{VT};
          pg8::gemm_phase<pg8::EpiVT, pg8::StaticOrder, true, true>(C.lds, g, S, E); }
        }
        GRID_BAR();
        for (int rep = 0; rep < NREP(64); ++rep) {
        if constexpr ((PHMASK & 64) != 0)
        { PHASE_CTX(); unsigned char* ws = WSP(); const bf16* PROJ = (const bf16*)(ws + WS_PROJ); const bf16* SGUW = (const bf16*)(ws + WS_SGU); bf16* YMIX = (bf16*)(ws + WS_YMIX);
          const float* sgu_b = INP(8); const float* out_norm_a = INP(9);
          for (int u = C.gw; u < BATCH * 16 * 8; u += C.NGW)
              gmlp_wave_unit(PROJ, SGUW + (size_t)l * 8 * 128 * 128, sgu_b + l * 8 * 128, out_norm_a + l * 512, YMIX, u, C.lane, C.lds + C.wave * 17408);
        }
        __syncthreads(); }
        for (int rep = 0; rep < NREP(128); ++rep) {
        if constexpr ((PHMASK & 128) != 0)
        { PHASE_CTX(); unsigned char* ws = WSP(); const bf16* PROJ = (const bf16*)(ws + WS_PROJ); const bf16* VT = (const bf16*)(ws + WS_VT); bf16* YMIX = (bf16*)(ws + WS_YMIX);
          const float* out_norm_b = INP(10);
          for (int it = C.gw; it < BATCH * 8 * 64; it += C.NGW) { const int qb = 63 - (it & 63), hd = (it >> 6) & 7, b = it >> 9;
            attn_item((const bf16*)(ws + WS_QI), (const bf16*)(ws + WS_KI), VT, YMIX, out_norm_b + l * 512, b, hd, qb, C.lane); } }
        __syncthreads(); }
        GRID_BAR();
        for (int rep = 0; rep < NREP(256); ++rep)
        if constexpr ((PHMASK & 256) != 0)
        { PHASE_CTX(); unsigned char* ws = WSP(); const bf16* YMIX = (const bf16*)(ws + WS_YMIX); const bf16* WOUT_T = (const bf16*)(ws + WS_WOUT); bf16* XRES = (bf16*)(ws + WS_XRES);
          const float* modl = (const float*)(ws + WS_MOD) + (size_t)l * BATCH * MODW; const float* x = INP(0);
          pg8::Gemm g{YMIX, WOUT_T + (size_t)l * DM * DM, NT, DM, DM}; pg8::StaticOrder S; S.init(NT, DM, C.G, (int)blockIdx.x);
          pg8::EpiResid E{l == 0 ? x : (const float*)nullptr, (const pg8::bf16_t*)XRES, (rep + 1 < NREP(256)) ? (pg8::bf16_t*)(GAS float*)ld_ptr(PT, 18) : (pg8::bf16_t*)XRES, modl + 2 * DM, FOLD ? (float*)(ws + WS_SS) : (float*)nullptr};
          pg8::gemm_phase<pg8::EpiResid, pg8::StaticOrder, true, true>(C.lds, g, S, E); }
        GRID_BAR();
        for (int rep = 0; rep < NREP(1024); ++rep)
        if constexpr ((PHMASK & 1024) != 0)
        { PHASE_CTX(); unsigned char* ws = WSP(); const bf16* XRES = (const bf16*)(ws + WS_XRES); const bf16* WQS = (const bf16*)(ws + WS_WQS); bf16* QP = (bf16*)(ws + WS_PROJ);
          pg8::Gemm g{XRES, WQS + (size_t)l * BATCH * DM * DM, NT, DM, DM}; pg8::BatchOrder S; S.init(NT, DM, C.G, (int)blockIdx.x); S.bs = (size_t)DM * DM * 2;
          pg8::EpiQ E{QP, (const float*)(ws + WS_SS), (const float*)(ws + WS_CVEC) + (size_t)l * BATCH * DM};
          pg8::gemm_phase<pg8::EpiQ, pg8::BatchOrder, true, true>(C.lds, g, S, E); }
        GRID_BAR();
        for (int rep = 0; rep < NREP(4096); ++rep)
        if constexpr ((PHMASK & 4096) != 0)
        { PHASE_CTX(); unsigned char* ws = WSP(); ExpertArgs A; A.commit = (rep + 1 == NREP(4096));
          const float* mod = (const float*)(ws + WS_MOD);
          A.U8 = ws + WS_U8 + (size_t)l * NEXP * TROW; A.V8 = ws + WS_V8 + (size_t)l * NEXP * TROWV; A.SUA = (const float*)(ws + WS_YMIX + 32 * MiB);
          A.IDX = (const int*)(ws + WS_YMIX); A.GATE = (const float*)(ws + WS_YMIX + 16 * MiB); A.XRES = (res_t*)(ws + WS_XRES);
          A.gt2 = mod + (size_t)l * BATCH * MODW + 5 * DM; A.last = (l == 1); A.out = (float*)(GAS float*)ld_ptr(PT, 18); A.final_g = INP(17);
          A.gs2 = (const float*)(ws + WS_GS) + (size_t)l * BATCH * DM; A.sh2 = mod + (size_t)l * BATCH * MODW + 3 * DM;
          A.HB_out = (bf16*)(ws + WS_HB); A.g_next = INP(4) + DM; A.sh_next = mod + (size_t)BATCH * MODW; A.sc_next = mod + (size_t)BATCH * MODW + DM;
              {
                { const bf16* K1B = (const bf16*)(ws + WS_K12); const bf16* K2B = K1B + 2 * 128 * 64; const bf16* k1 = K1B + l * 128 * 64; const bf16* k2 = K2B + l * 128 * 64;
                  __syncthreads();
                  for (int i = C.tid; i < 2 * 128 * 8; i += NTHR) { const int tb = i >> 10, r = (i >> 3) & 127, c = i & 7;
                      *(LAS v4u*)(C.lds + tb * 18432 + r * 144 + c * 16) = *(const v4u*)((tb ? k2 : k1) + r * 64 + c * 8); }
                  __syncthreads(); }
                for (int blk = C.vcu; blk < NT / 32; blk += C.G) {
                    v2u xr[4][4]; f32x4 gg[4], s0[4];
                    { const int ln_ = lane_now(); const size_t tk0_ = (size_t)(32 * blk + 4 * C.wave); const int b_ = (32 * blk) >> 11;
#pragma unroll
                      for (int t = 0; t < 4; ++t)
#pragma unroll
                          for (int j = 0; j < 4; ++j) xr[t][j] = ((const v2u*)(A.XRES + (tk0_ + t) * DM))[ln_ + 64 * j];
#pragma unroll
                      for (int j = 0; j < 4; ++j) { gg[j] = ((const f32x4*)(A.gs2 + (size_t)b_ * DM))[ln_ + 64 * j]; s0[j] = ((const f32x4*)(A.sh2 + (size_t)b_ * MODW))[ln_ + 64 * j]; } }
                    { unsigned char* wr_ = WSP();
                      route_item((const bf16*)(wr_ + WS_PROJ), C.lds, C.lds + 18432, (const float*)(wr_ + WS_SCL) + l * NEXP, (const float*)(wr_ + WS_SCL) + 2 * NEXP + l * NEXP,
                                 (int*)(wr_ + WS_YMIX), (float*)(wr_ + WS_YMIX + 16 * MiB), (float*)(wr_ + WS_YMIX + 32 * MiB), blk, C.wave, lane_now()); }
                    __syncthreads();
                    asm volatile("buffer_inv sc0" ::: "memory");
                    expert_rr4<0>(A, 32 * blk + 4 * C.wave, 1, lane_now(), xr, gg, s0); } } }
        if (l == 0) GRID_BAR();
    }
}
}

extern "C" void kernel_launch(void* const* d_in, const int* in_sizes, int n_in, void* d_out, int out_size, void* d_ws, size_t ws_size, hipStream_t stream) {
    using namespace mk;
    static int grid = 0;
    if (grid == 0) {
        if (n_in != 18 || ws_size < WS_END) { fprintf(stderr, "kernel_launch: unexpected n_in %d or ws_size %zu (< %zu)\n", n_in, ws_size, (size_t)WS_END); grid = -1; return; }
        int dev = 0, cus = 0, per_cu = 0;
        if (hipGetDevice(&dev) != hipSuccess || hipDeviceGetAttribute(&cus, hipDeviceAttributeMultiprocessorCount, dev) != hipSuccess) { grid = -1; return; }
        if (hipFuncSetAttribute((const void*)mega_fwd, hipFuncAttributeMaxDynamicSharedMemorySize, LDS_BYTES) != hipSuccess) { fprintf(stderr, "kernel_launch: hipFuncSetAttribute failed\n"); grid = -1; return; }
        if (hipOccupancyMaxActiveBlocksPerMultiprocessor(&per_cu, (const void*)mega_fwd, NTHR, LDS_BYTES) != hipSuccess || per_cu < 1)
            fprintf(stderr, "kernel_launch: occupancy query reports %d workgroups per CU\n", per_cu);
        (void)hipGetLastError();
        grid = cus;
    }
    if (grid < 0) return;
    (void)hipMemsetAsync((char*)d_ws + WS_CTL, 0, CTL_ZERO_BYTES, stream);
    Args a{};
    for (int i = 0; i < 18; ++i) a.in[i] = (const float*)d_in[i];
    a.out = (float*)d_out; a.ws = (unsigned char*)d_ws; a.dbg = 0; a.pad = 0;
    hipLaunchKernelGGL(mega_fwd, dim3(grid), dim3(NTHR), LDS_BYTES, stream, a);
}
```
